# Optimizing an MI355X kernel written in HIP

```python
import math
import jax, jax.numpy as jnp
from jax import lax
import numpy as np


D_MODEL = 1024
BATCH = 4
SEQ = 8192
DEPTH = 2
DEC_BATCH = 2
DEC_SEQ = 8192
PAST_LEN = 128

N_BRANCH = 4
BR_W = D_MODEL // 4
D_FF = ((8 * D_MODEL // 3 + 127) // 128) * 128
SHORT_CONV = 3
CHUNK = 64
EPS = 1e-6
HY_C = BR_W
HY_ORDER = 2
HY_BANDS = 16
HY_EMB = 1 + 2 * HY_BANDS
HY_FH = 64
HY_DECAY_MIN = 3.07
HY_DECAY_MAX = 15.35
M2_H = 4
M2_P = BR_W // M2_H
M2_N = 64
M2_G = 2
M2_W = BR_W
GLA_H = 4
GLA_DV = BR_W // GLA_H
GLA_DK = GLA_DV // 2
GLA_R = 16
GLA_GATE_NORM = 16.0
HG_H = 4
HG_DK = BR_W // HG_H
HG_DV = BR_W // HG_H

SPLIT_SIZES = (
    3 * HY_C,
    M2_W,
    M2_W + 2 * M2_G * M2_N,
    2 * M2_H,
    GLA_H * GLA_DK,
    GLA_H * GLA_DK,
    GLA_H * GLA_DV,
    2 * GLA_R,
    GLA_H * GLA_DV,
    HG_H * HG_DK,
    2 * HG_H * HG_DK,
    HG_H * HG_DV,
    HG_H * HG_DV,
    N_BRANCH * D_MODEL,
)
N_IN = sum(SPLIT_SIZES)
SPLIT_POINTS = tuple(int(s) for s in np.cumsum(SPLIT_SIZES)[:-1])

kernel_name = 'hybrid_bidir_hyena_ssd_gla_hgrn2_encoder'


def rms_norm(x, w):
    xf = x.astype(jnp.float32)
    y = xf * lax.rsqrt(jnp.mean(xf * xf, axis=-1, keepdims=True) + EPS)
    return (y * w.astype(jnp.float32)).astype(x.dtype)


def swiglu(x, w_gu, w_down):
    gate, up = jnp.split(x @ w_gu, 2, axis=-1)
    return (jax.nn.silu(gate) * up) @ w_down


def short_conv(x, w, b):
    K = w.shape[0]
    pad = K // 2
    L = x.shape[1]
    xp = jnp.pad(x, ((0, 0), (pad, pad), (0, 0)))
    out = b
    for k in range(K):
        out = out + xp[:, k:k + L] * w[k]
    return out


def _fb(fwd, bwd):
    return jnp.concatenate([fwd, jnp.flip(bwd, axis=1)], axis=2)


def _unfb(o, h):
    return o[:, :, :h] + jnp.flip(o[:, :, h:], axis=1)


def _to_chunks(t):
    b, l, h, d = t.shape
    return t.reshape(b, l // CHUNK, CHUNK, h, d).transpose(1, 0, 3, 2, 4)


def _from_chunks(t):
    nc, b, h, c, d = t.shape
    return t.transpose(1, 0, 3, 2, 4).reshape(b, nc * c, h, d)


def _masked_exp(diff, mask):
    return jnp.where(mask, jnp.exp(jnp.where(mask, diff, 0.0)), 0.0)


def chunked_gla(q, k, v, log_a):
    f32 = jnp.float32
    b, l, h, dk = q.shape
    dv = v.shape[-1]
    mask = jnp.tril(jnp.ones((CHUNK, CHUNK), dtype=bool))

    def step(S, inp):
        qc, kc, vc, gc = inp
        cb = jnp.cumsum(gc, axis=2)
        cb_last = cb[:, :, -1:]
        o = jnp.einsum('bhtd,bhde->bhte', qc * jnp.exp(cb), S)
        decay = _masked_exp(cb[:, :, :, None] - cb[:, :, None], mask[:, :, None])
        att = jnp.einsum('bhtd,bhsd,bhtsd->bhts', qc, kc, decay)
        o = o + jnp.einsum('bhts,bhse->bhte', att, vc)
        S = jnp.exp(cb_last[:, :, 0])[..., None] * S + jnp.einsum(
            'bhsd,bhse->bhde', kc * jnp.exp(cb_last - cb), vc)
        return S, o

    S0 = jnp.zeros((b, h, dk, dv), f32)
    xs = tuple(_to_chunks(t.astype(f32)) for t in (q, k, v, log_a))
    _, o = lax.scan(step, S0, xs)
    return _from_chunks(o).astype(v.dtype)


def chunked_ssd(x, dt, A, Bm, Cm):
    f32 = jnp.float32
    b, l, h, p = x.shape
    n = Bm.shape[-1]
    mask = jnp.tril(jnp.ones((CHUNK, CHUNK), dtype=bool))
    A = A.astype(f32)

    def step(S, inp):
        xc, dtc, Bc, Cc = inp
        dtc = dtc[..., 0]
        cum = jnp.cumsum(dtc * A[:, None], axis=-1)
        seg = _masked_exp(cum[..., :, None] - cum[..., None, :], mask)
        xdt = xc * dtc[..., None]
        scores = jnp.einsum('bhtn,bhsn->bhts', Cc, Bc) * seg
        y = jnp.einsum('bhts,bhsp->bhtp', scores, xdt) + jnp.einsum(
            'bhtn,bhnp->bhtp', Cc * jnp.exp(cum)[..., None], S)
        S = jnp.exp(cum[..., -1])[..., None, None] * S + jnp.einsum(
            'bhsn,bhsp->bhnp', Bc * jnp.exp(cum[..., -1:] - cum)[..., None], xdt)
        return S, y

    S0 = jnp.zeros((b, h, n, p), f32)
    xs = (_to_chunks(x.astype(f32)), _to_chunks(dt.astype(f32)[..., None]),
          _to_chunks(Bm.astype(f32)), _to_chunks(Cm.astype(f32)))
    _, y = lax.scan(step, S0, xs)
    return _from_chunks(y).astype(x.dtype)


def hyena_filter_spectra(L, w1, b1, w2, b2, freq, w3, decay):
    f32 = jnp.float32
    t = jnp.linspace(0.0, 1.0, L, dtype=f32)[:, None]
    bands = jnp.linspace(1e-4, HY_BANDS - 1, HY_BANDS, dtype=f32)
    w = (2.0 * math.pi / L) * jnp.arange(L, dtype=f32)[:, None]
    z = jnp.concatenate([t, jnp.cos(bands * w), -jnp.sin(bands * w)], axis=-1)
    freq = freq.astype(f32)
    h = jnp.sin(freq[0] * (z @ w1.astype(f32) + b1.astype(f32)))
    h = jnp.sin(freq[1] * (h @ w2.astype(f32) + b2.astype(f32)))
    h = (h @ w3.astype(f32)) * jnp.exp(-t * jnp.abs(decay.astype(f32)))
    h = h.reshape(L, HY_ORDER, 2, HY_C)
    hf, hb = h[:, :, 0], h[:, :, 1]
    g = jnp.concatenate([hf, jnp.zeros((1, HY_ORDER, HY_C), f32), jnp.flip(hb, axis=0)[:L - 1]], axis=0)
    return jnp.fft.rfft(g, axis=0)


def fft_long_conv(u, spec, bias):
    L = u.shape[1]
    uf = u.astype(jnp.float32)
    y = jnp.fft.irfft(jnp.fft.rfft(uf, n=2 * L, axis=1) * spec, n=2 * L, axis=1)[:, :L]
    return (y + uf * bias.astype(jnp.float32)).astype(u.dtype)


def mixer(h, lp):
    f32 = jnp.float32
    bsz, L, _ = h.shape
    (hy_in, m2_z, m2_xbc, m2_dt, gla_q, gla_k, gla_v, gla_a, gla_g,
     hg_q, hg_f, hg_i, hg_g, gate_in) = jnp.split(h @ lp['w_in'], SPLIT_POINTS, axis=-1)

    u = short_conv(hy_in, lp['hy_conv_w'], lp['hy_conv_b'])
    v, x1, x2 = jnp.split(u, 3, axis=-1)
    spec = hyena_filter_spectra(L, lp['hy_filt_w1'], lp['hy_filt_b1'], lp['hy_filt_w2'], lp['hy_filt_b2'],
                                lp['hy_filt_freq'], lp['hy_filt_w3'], lp['hy_decay'])
    z = x1 * fft_long_conv(v, spec[:, 0], lp['hy_bias'][0])
    y_a = x2 * fft_long_conv(z, spec[:, 1], lp['hy_bias'][1])

    xbc = jax.nn.silu(short_conv(m2_xbc, lp['m2_conv_w'], lp['m2_conv_b']))
    mx, mB, mC = jnp.split(xbc, [M2_W, M2_W + M2_G * M2_N], axis=-1)
    mx = mx.reshape(bsz, L, M2_H, M2_P)
    rep = M2_H // M2_G
    mB = jnp.repeat(mB.reshape(bsz, L, M2_G, M2_N), rep, axis=2)
    mC = jnp.repeat(mC.reshape(bsz, L, M2_G, M2_N), rep, axis=2)
    dt = jax.nn.softplus((m2_dt + lp['m2_dt_bias']).astype(f32)).reshape(bsz, L, 2, M2_H)
    A = -jnp.exp(lp['m2_A_log'].astype(f32))
    y = chunked_ssd(_fb(mx, mx), _fb(dt[:, :, 0], dt[:, :, 1]), A, _fb(mB, mB), _fb(mC, mC))
    y = _unfb(y, M2_H) + lp['m2_D'][:, None] * mx
    y_b = rms_norm(y.reshape(bsz, L, M2_W) * jax.nn.silu(m2_z), lp['m2_norm'])

    q = gla_q.reshape(bsz, L, GLA_H, GLA_DK) * GLA_DK ** -0.5
    k = gla_k.reshape(bsz, L, GLA_H, GLA_DK)
    v = gla_v.reshape(bsz, L, GLA_H, GLA_DV)
    la = jnp.einsum('blcr,crk->blck', gla_a.reshape(bsz, L, 2, GLA_R), lp['gla_w_gate2']) + lp['gla_b_gate']
    la = (jax.nn.log_sigmoid(la.astype(f32)) / GLA_GATE_NORM).reshape(bsz, L, 2, GLA_H, GLA_DK)
    o = _unfb(chunked_gla(_fb(q, q), _fb(k, k), _fb(v, v), _fb(la[:, :, 0], la[:, :, 1])), GLA_H)
    y_c = (rms_norm(o, lp['gla_norm']) * jax.nn.silu(gla_g.reshape(bsz, L, GLA_H, GLA_DV))).reshape(bsz, L, BR_W)

    lb = lp['hg_lb'].reshape(2, HG_H, HG_DK)
    zf = hg_f.reshape(bsz, L, 2, HG_H, HG_DK).astype(f32)
    log_f = jax.nn.log_sigmoid(zf) + jnp.log1p(lb * jnp.exp(-zf))
    kf = (1.0 - lb) * jax.nn.sigmoid(-zf)
    q = hg_q.reshape(bsz, L, HG_H, HG_DK) * HG_DK ** -0.5
    i = hg_i.reshape(bsz, L, HG_H, HG_DV)
    o = _unfb(chunked_gla(_fb(q, q), _fb(kf[:, :, 0], kf[:, :, 1]), _fb(i, i),
                          _fb(log_f[:, :, 0], log_f[:, :, 1])), HG_H)
    y_d = (rms_norm(o, lp['hg_norm']) * jax.nn.silu(hg_g.reshape(bsz, L, HG_H, HG_DV))).reshape(bsz, L, BR_W)

    gates = jax.nn.sigmoid(gate_in.reshape(bsz, L, N_BRANCH, D_MODEL))
    ys = (y_a, y_b, y_c, y_d)
    merged = sum(gates[:, :, n] * (ys[n] @ lp['w_branch'][n]) for n in range(N_BRANCH))
    return merged @ lp['w_out']


def encoder(x, p):
    for l in range(DEPTH):
        lp = {name: arr[l] for name, arr in p.items()}
        x = x + 0.5 * rms_norm(swiglu(rms_norm(x, lp['ffn1_norm_pre']), lp['ffn1_w_gu'], lp['ffn1_w_down']),
                               lp['ffn1_norm_post'])
        x = x + rms_norm(mixer(rms_norm(x, lp['mix_norm_pre']), lp), lp['mix_norm_post'])
        x = x + 0.5 * rms_norm(swiglu(rms_norm(x, lp['ffn2_norm_pre']), lp['ffn2_w_gu'], lp['ffn2_w_down']),
                               lp['ffn2_norm_post'])
    return x


def setup_inputs(seed: int = 0) -> dict:
    key = jax.random.key(seed)
    keys = iter(jax.random.split(key, 48))
    f32 = jnp.float32

    def nrm(shape, scale):
        return scale * jax.random.normal(next(keys), shape, f32)

    def gain(n):
        return 1.0 + nrm((DEPTH, n), 0.02)

    xbc_w = M2_W + 2 * M2_G * M2_N
    dt = jnp.exp(jax.random.uniform(next(keys), (DEPTH, 2 * M2_H), f32, math.log(1e-3), math.log(1e-1)))
    dt_bias = dt + jnp.log(-jnp.expm1(-dt))
    a_log = jnp.log(jax.random.uniform(next(keys), (DEPTH, 2 * M2_H), f32, 1.0, 16.0))
    decay = jnp.linspace(HY_DECAY_MIN, HY_DECAY_MAX, 4 * HY_C, dtype=f32)[None, :] * (1.0 + nrm((DEPTH, 4 * HY_C), 0.05))
    return {
        'x_prompt': nrm((BATCH, SEQ, D_MODEL), 1.0),
        'x_sample': nrm((DEC_BATCH, DEC_SEQ, D_MODEL), 1.0),
        'ffn1_norm_pre': gain(D_MODEL),
        'ffn1_norm_post': gain(D_MODEL),
        'ffn1_w_gu': nrm((DEPTH, D_MODEL, 2 * D_FF), D_MODEL ** -0.5),
        'ffn1_w_down': nrm((DEPTH, D_FF, D_MODEL), D_FF ** -0.5),
        'mix_norm_pre': gain(D_MODEL),
        'mix_norm_post': gain(D_MODEL),
        'w_in': nrm((DEPTH, D_MODEL, N_IN), D_MODEL ** -0.5),
        'hy_conv_w': nrm((DEPTH, SHORT_CONV, 3 * HY_C), SHORT_CONV ** -0.5),
        'hy_conv_b': nrm((DEPTH, 3 * HY_C), 0.02),
        'hy_filt_w1': nrm((DEPTH, HY_EMB, HY_FH), HY_EMB ** -0.5),
        'hy_filt_b1': nrm((DEPTH, HY_FH), 0.1),
        'hy_filt_w2': nrm((DEPTH, HY_FH, HY_FH), HY_FH ** -0.5),
        'hy_filt_b2': nrm((DEPTH, HY_FH), 0.1),
        'hy_filt_freq': 1.0 + nrm((DEPTH, 2, HY_FH), 0.05),
        'hy_filt_w3': nrm((DEPTH, HY_FH, 4 * HY_C), 0.1 * HY_FH ** -0.5),
        'hy_decay': decay,
        'hy_bias': nrm((DEPTH, HY_ORDER, HY_C), 0.1),
        'm2_conv_w': nrm((DEPTH, SHORT_CONV, xbc_w), SHORT_CONV ** -0.5),
        'm2_conv_b': nrm((DEPTH, xbc_w), 0.02),
        'm2_dt_bias': dt_bias,
        'm2_A_log': a_log,
        'm2_D': 1.0 + nrm((DEPTH, M2_H), 0.1),
        'm2_norm': gain(M2_W),
        'gla_w_gate2': nrm((DEPTH, 2, GLA_R, GLA_H * GLA_DK), GLA_R ** -0.5),
        'gla_b_gate': nrm((DEPTH, 2, GLA_H * GLA_DK), 0.1),
        'gla_norm': gain(GLA_DV),
        'hg_lb_param': nrm((DEPTH, 2, HG_H * HG_DK), 1.0),
        'hg_norm': gain(HG_DV),
        'w_branch': nrm((DEPTH, N_BRANCH, BR_W, D_MODEL), BR_W ** -0.5),
        'w_out': nrm((DEPTH, D_MODEL, D_MODEL), D_MODEL ** -0.5),
        'ffn2_norm_pre': gain(D_MODEL),
        'ffn2_norm_post': gain(D_MODEL),
        'ffn2_w_gu': nrm((DEPTH, D_MODEL, 2 * D_FF), D_MODEL ** -0.5),
        'ffn2_w_down': nrm((DEPTH, D_FF, D_MODEL), D_FF ** -0.5),
    }


def reference(x_prompt, x_sample,
              ffn1_norm_pre, ffn1_norm_post, ffn1_w_gu, ffn1_w_down,
              mix_norm_pre, mix_norm_post, w_in,
              hy_conv_w, hy_conv_b, hy_filt_w1, hy_filt_b1, hy_filt_w2, hy_filt_b2,
              hy_filt_freq, hy_filt_w3, hy_decay, hy_bias,
              m2_conv_w, m2_conv_b, m2_dt_bias, m2_A_log, m2_D, m2_norm,
              gla_w_gate2, gla_b_gate, gla_norm,
              hg_lb_param, hg_norm,
              w_branch, w_out,
              ffn2_norm_pre, ffn2_norm_post, ffn2_w_gu, ffn2_w_down):
    pl = jax.nn.softmax(hg_lb_param.astype(jnp.float32), axis=0)
    hg_lb = jnp.cumsum(pl, axis=0) - pl[0]
    params = {
        'ffn1_norm_pre': ffn1_norm_pre, 'ffn1_norm_post': ffn1_norm_post,
        'ffn1_w_gu': ffn1_w_gu, 'ffn1_w_down': ffn1_w_down,
        'mix_norm_pre': mix_norm_pre, 'mix_norm_post': mix_norm_post, 'w_in': w_in,
        'hy_conv_w': hy_conv_w, 'hy_conv_b': hy_conv_b,
        'hy_filt_w1': hy_filt_w1, 'hy_filt_b1': hy_filt_b1, 'hy_filt_w2': hy_filt_w2, 'hy_filt_b2': hy_filt_b2,
        'hy_filt_freq': hy_filt_freq, 'hy_filt_w3': hy_filt_w3, 'hy_decay': hy_decay, 'hy_bias': hy_bias,
        'm2_conv_w': m2_conv_w, 'm2_conv_b': m2_conv_b, 'm2_dt_bias': m2_dt_bias, 'm2_A_log': m2_A_log,
        'm2_D': m2_D, 'm2_norm': m2_norm,
        'gla_w_gate2': gla_w_gate2, 'gla_b_gate': gla_b_gate, 'gla_norm': gla_norm,
        'hg_lb': hg_lb, 'hg_norm': hg_norm,
        'w_branch': w_branch, 'w_out': w_out,
        'ffn2_norm_pre': ffn2_norm_pre, 'ffn2_norm_post': ffn2_norm_post,
        'ffn2_w_gu': ffn2_w_gu, 'ffn2_w_down': ffn2_w_down,
    }
    y_prompt = encoder(x_prompt, params)
    y_sample = encoder(x_sample, params)
    return (y_prompt, y_sample)
```

```cpp
#include <hip/hip_runtime.h>
#include <hip/hip_cooperative_groups.h>
#include <cstdio>
namespace cg = cooperative_groups;

#define LAS __attribute__((address_space(3)))
typedef unsigned short bf16_t;
typedef short bf16x8 __attribute__((ext_vector_type(8)));
typedef float f32x4 __attribute__((ext_vector_type(4)));
typedef unsigned u32x4 __attribute__((ext_vector_type(4)));
typedef unsigned u32x2 __attribute__((ext_vector_type(2)));

constexpr int DM = 1024, SEQ = 8192, DFF = 2816;
constexpr int GS = 2, MG = GS * SEQ, NGRP = 3;
constexpr int NPROJ = 3840, NIN = 7720, NNG = 3624;
constexpr int SCW = 1280;
constexpr int FN = 16384;
constexpr int SPP = 8200;
constexpr float EPS = 1e-6f;
constexpr int C_HY = 0, C_M2Z = 768, C_XBC = 1024, C_DT = 1536, C_GQ = 1544, C_GK = 1672, C_GV = 1800, C_GA = 2056, C_GG = 2088,
              C_HQ = 2344, C_HF = 2600, C_HI = 3112, C_HGG = 3368;
constexpr size_t WS_GU1 = 0;
constexpr size_t WS_DN1 = WS_GU1 + (size_t)5632 * 1024 * 2;
constexpr size_t WS_INT = WS_DN1 + (size_t)1024 * 2816 * 2;
constexpr size_t WS_GT  = WS_INT + (size_t)NPROJ * 1024 * 2;
constexpr size_t WS_BR  = WS_GT + (size_t)4096 * 1024 * 2;
constexpr size_t WS_OUT = WS_BR + (size_t)4 * 1024 * 256 * 2;
constexpr size_t WS_GU2 = WS_OUT + (size_t)1024 * 1024 * 2;
constexpr size_t WS_DN2 = WS_GU2 + (size_t)5632 * 1024 * 2;
constexpr size_t WS_H2  = WS_DN2 + (size_t)1024 * 2816 * 2;
constexpr size_t WS_SP  = WS_H2 + (size_t)8192 * 64 * 4;
constexpr size_t WS_XN  = WS_SP + (size_t)256 * SPP * 16;
constexpr size_t WS_PROJ = WS_XN + (size_t)MG * 1024 * 2;
constexpr size_t WS_SC  = WS_PROJ + (size_t)MG * NPROJ * 2;
constexpr size_t WS_DTA = WS_SC + (size_t)MG * SCW * 2;
constexpr size_t WS_SO  = WS_DTA + (size_t)MG * 16 * 4;
constexpr size_t WS_YS  = WS_SO + (size_t)2 * MG * 768 * 2;
constexpr size_t WS_TMP = WS_YS + (size_t)MG * 1024 * 2;
constexpr size_t WS_END = WS_TMP + (size_t)MG * 1024 * 2;
constexpr int LDS_BYTES = 131072 + 4096;

struct KArgs { const float* in[36]; float* out; unsigned char* ws; int ph_lo, ph_hi; };

__device__ __forceinline__ float bf_lo(unsigned w) { return __uint_as_float(w << 16); }
__device__ __forceinline__ float bf_hi(unsigned w) { return __uint_as_float(w & 0xffff0000u); }
__device__ __forceinline__ float bf2f(bf16_t b) { return __uint_as_float(((unsigned)b) << 16); }
__device__ __forceinline__ bf16_t f2bf(float f) { unsigned u = __float_as_uint(f); u += 0x7FFFu + ((u >> 16) & 1u); return (bf16_t)(u >> 16); }
__device__ __forceinline__ unsigned pk_bf16(float lo, float hi) { unsigned r; asm volatile("v_cvt_pk_bf16_f32 %0, %1, %2" : "=v"(r) : "v"(lo), "v"(hi)); return r; }
__device__ __forceinline__ float sigmoidf_(float x) { return __builtin_amdgcn_rcpf(1.0f + __expf(-x)); }
__device__ __forceinline__ float siluf_(float x) { return x * sigmoidf_(x); }
__device__ __forceinline__ float softplusf_(float x) { return fmaxf(x, 0.f) + __logf(1.0f + __expf(-fabsf(x))); }
__device__ __forceinline__ float sin_rad(float x) { return __builtin_amdgcn_sinf(x * 0.15915494309189535f); }
__device__ __forceinline__ float wave_sum(float v) {
#pragma unroll
    for (int o = 32; o >= 1; o >>= 1) v += __shfl_xor(v, o);
    return v;
}


__device__ __forceinline__ int tidx() { int t = threadIdx.x; asm volatile("" : "+v"(t)); return t; }
__device__ __forceinline__ int bidx() { int b = blockIdx.x; asm volatile("" : "+s"(b)); return b; }
__device__ __forceinline__ int gdim() { int g = gridDim.x; asm volatile("" : "+s"(g)); return g; }

namespace pg8 {
constexpr int BM = 256, BK = 64, HALF = 128, HTB = HALF * BK * 2, NXCD = 8, WGM = 8;
__device__ __forceinline__ int lds_byte(int r, int c) { const int st = (r >> 4) * 2 + (c >> 5), rr = r & 15, cc = c & 31, ob = rr * 64 + cc * 2; return st * 1024 + (ob ^ (((ob >> 9) & 1) << 5)); }
__device__ __forceinline__ void stage_rc(int b, int& R, int& C) { const int st = b / 1024, sb = b % 1024, swz = sb ^ (((sb >> 9) & 1) << 5); R = (st >> 1) * 16 + swz / 64; C = (st & 1) * 32 + (swz % 64) / 2; }
__device__ __forceinline__ int perm32(int rho) { const int n = rho >> 4, i = rho & 15; return 8 * (i >> 2) + 4 * n + (i & 3); }
struct Unit { int pm, pn; };
struct Gemm { const bf16_t* A; const bf16_t* Bt; int M, N, K, lda, ldb; };
struct StaticOrder {
    int nM, nN, nwg, G, c;
    __device__ void init(int M, int N, int G_, int c_) { nM = M / BM; nN = N / BM; nwg = nM * nN; G = G_; c = c_; }
    __device__ bool next(int i, Unit& u) const {
        const long L = (long)i * G + c; if (L >= nwg) return false;
        int wgid = (int)L; { const int q = nwg / NXCD, r = nwg % NXCD, xcd = wgid % NXCD, off = wgid / NXCD; wgid = (xcd < r ? xcd * (q + 1) : r * (q + 1) + (xcd - r) * q) + off; }
        const int nig = WGM * nN, gid = wgid / nig, fm = gid * WGM, gsz = (nM - fm) < WGM ? (nM - fm) : WGM;
        u.pm = fm + ((wgid % nig) % gsz); u.pn = (wgid % nig) / gsz; return true;
    }
};

template <class Epi>
__device__ __forceinline__ void gemm_phase(LAS unsigned char* lds, const Gemm g, const StaticOrder& S, const Epi& E) {
    const int tid = tidx(), wid = __builtin_amdgcn_readfirstlane(tid >> 6), lane = tid & 63, wr = wid >> 2, wc = wid & 3, fr = lane & 15, fq = lane >> 4;
    const int K = g.K, nt = K / BK;
    unsigned voffA[2], voffB[2];
#pragma unroll
    for (int i = 0; i < 2; ++i) { int R, C; stage_rc(tid * 16 + i * 8192, R, C); const int Rb = Epi::PERM ? ((R & ~31) + perm32(R & 31)) : R;
        voffA[i] = (unsigned)(R * g.lda + C) * 2u; voffB[i] = (unsigned)(Rb * g.ldb + C) * 2u; }
    const size_t kstep = (size_t)(BK * 2);
    const size_t hstepA = (size_t)HALF * g.lda * 2, hstepB = (size_t)HALF * g.ldb * 2;
    const size_t tstepA = 2 * hstepA, tstepB = 2 * hstepB;
    const unsigned ldsw = (unsigned)wid * 1024u;
    const int aoff = lds_byte(wr * 64 + fr, fq * 8), boff = lds_byte(wc * 32 + fr, fq * 8);
#define PG8_SA(b, h) (((b) * 2 + (h)) * HTB)
#define PG8_SB(b, h) ((4 + (b) * 2 + (h)) * HTB)
#define PG8_STAGE(bufoff, gbase, voff) do { _Pragma("unroll") for (int _i = 0; _i < 2; ++_i) \
        __builtin_amdgcn_global_load_lds((const unsigned*)((const char*)(gbase) + (voff)[_i]), (LAS unsigned*)(lds + (bufoff) + ldsw + _i * 8192), 16, 0, 0); } while (0)
#define PG8_LDA(dst, b, h) do { _Pragma("unroll") for (int m = 0; m < 4; ++m) _Pragma("unroll") for (int k = 0; k < 2; ++k) dst[m][k] = *(const LAS bf16x8*)(lds + PG8_SA(b, h) + aoff + m * 2048 + k * 1024); } while (0)
#define PG8_LDB(dst, b, h) do { _Pragma("unroll") for (int n = 0; n < 2; ++n) _Pragma("unroll") for (int k = 0; k < 2; ++k) dst[n][k] = *(const LAS bf16x8*)(lds + PG8_SB(b, h) + boff + n * 2048 + k * 1024); } while (0)
#define PG8_MMA(ai, bj, At, Bt) do { __builtin_amdgcn_s_setprio(1); _Pragma("unroll") for (int m = 0; m < 4; ++m) _Pragma("unroll") for (int n = 0; n < 2; ++n) _Pragma("unroll") for (int k = 0; k < 2; ++k) \
        acc[ai][bj][m][n] = __builtin_amdgcn_mfma_f32_16x16x32_bf16(Bt[n][k], At[m][k], acc[ai][bj][m][n], 0, 0, 0); __builtin_amdgcn_s_setprio(0); } while (0)
#define PG8_WAIT_V(n) asm volatile("s_waitcnt vmcnt(" #n ")" ::: "memory")
#define PG8_WAIT_L(n) asm volatile("s_waitcnt lgkmcnt(" #n ")" ::: "memory")
#define PG8_BAR __builtin_amdgcn_s_barrier()
#define PG8_SCHED __builtin_amdgcn_sched_barrier(0)
    Unit cur, nxt; int ui = 0;
    if (!S.next(0, cur)) return;
    f32x4 acc[2][2][4][2];
#pragma unroll
    for (int a = 0; a < 2; ++a)
#pragma unroll
        for (int b = 0; b < 2; ++b)
#pragma unroll
            for (int m = 0; m < 4; ++m)
#pragma unroll
                for (int n = 0; n < 2; ++n) acc[a][b][m][n] = (f32x4){0.f, 0.f, 0.f, 0.f};
    bf16x8 At[4][2], B0[2][2], B1[2][2];
    const char* cA = (const char*)g.A + (size_t)cur.pm * tstepA; const char* cB = (const char*)g.Bt + (size_t)cur.pn * tstepB;
    PG8_STAGE(PG8_SB(0, 0), cB, voffB); PG8_STAGE(PG8_SA(0, 0), cA, voffA); PG8_STAGE(PG8_SB(0, 1), cB + hstepB, voffB); PG8_STAGE(PG8_SA(0, 1), cA + hstepA, voffA);
    if (wr == 1) PG8_BAR;
    PG8_WAIT_V(4); PG8_BAR;
    PG8_STAGE(PG8_SB(1, 0), cB + kstep, voffB); PG8_STAGE(PG8_SA(1, 0), cA + kstep, voffA); PG8_STAGE(PG8_SB(1, 1), cB + hstepB + kstep, voffB);
    PG8_WAIT_V(6); PG8_BAR;
    for (;;) {
        const bool has_next = S.next(ui + 1, nxt);
        const char* nA = has_next ? (const char*)g.A + (size_t)nxt.pm * tstepA : cA; const char* nB = has_next ? (const char*)g.Bt + (size_t)nxt.pn * tstepB : cB;
        for (int t = 0; t < nt; t += 2) {
            const bool last = (t == nt - 2);
            const char* a1 = cA + (size_t)(t + 1) * kstep;
            const char* a2 = last ? nA : cA + (size_t)(t + 2) * kstep; const char* b2 = last ? nB : cB + (size_t)(t + 2) * kstep;
            const char* a3 = a2 + kstep; const char* b3 = b2 + kstep;
            PG8_LDB(B0, 0, 0); PG8_SCHED; PG8_LDA(At, 0, 0); PG8_STAGE(PG8_SA(1, 1), a1 + hstepA, voffA);
            PG8_WAIT_L(8); PG8_BAR; PG8_WAIT_L(0); PG8_MMA(0, 0, At, B0); PG8_BAR; PG8_SCHED;
            PG8_LDB(B1, 0, 1); PG8_STAGE(PG8_SB(0, 0), b2, voffB);
            PG8_BAR; PG8_WAIT_L(0); PG8_MMA(0, 1, At, B1); PG8_BAR;
            PG8_LDA(At, 0, 1); PG8_STAGE(PG8_SA(0, 0), a2, voffA);
            PG8_BAR; PG8_WAIT_L(0); PG8_MMA(1, 0, At, B0); PG8_BAR; PG8_SCHED;
            PG8_STAGE(PG8_SB(0, 1), b2 + hstepB, voffB);
            PG8_WAIT_V(6); PG8_BAR; PG8_MMA(1, 1, At, B1); PG8_BAR;
            PG8_LDB(B0, 1, 0); PG8_SCHED; PG8_LDA(At, 1, 0); PG8_STAGE(PG8_SA(0, 1), a2 + hstepA, voffA);
            PG8_WAIT_L(8); PG8_BAR; PG8_WAIT_L(0); PG8_MMA(0, 0, At, B0); PG8_BAR; PG8_SCHED;
            PG8_LDB(B1, 1, 1); PG8_STAGE(PG8_SB(1, 0), b3, voffB);
            PG8_BAR; PG8_WAIT_L(0); PG8_MMA(0, 1, At, B1); PG8_BAR;
            PG8_LDA(At, 1, 1); PG8_STAGE(PG8_SA(1, 0), a3, voffA);
            PG8_BAR; PG8_WAIT_L(0); PG8_MMA(1, 0, At, B0); PG8_BAR; PG8_SCHED;
            PG8_STAGE(PG8_SB(1, 1), b3 + hstepB, voffB);
            PG8_WAIT_V(6); PG8_BAR; PG8_MMA(1, 1, At, B1); PG8_BAR;
        }
        E(acc, cur, wr, wc, fr, fq);
        if (!has_next) break;
#pragma unroll
        for (int a = 0; a < 2; ++a)
#pragma unroll
            for (int b = 0; b < 2; ++b)
#pragma unroll
                for (int m = 0; m < 4; ++m)
#pragma unroll
                    for (int n = 0; n < 2; ++n) acc[a][b][m][n] = (f32x4){0.f, 0.f, 0.f, 0.f};
        cur = nxt; cA = nA; cB = nB; ++ui;
    }
    PG8_WAIT_V(0);
    if (wr == 0) PG8_BAR;
    PG8_BAR;
#undef PG8_SA
#undef PG8_SB
#undef PG8_STAGE
#undef PG8_LDA
#undef PG8_LDB
#undef PG8_MMA
#undef PG8_WAIT_V
#undef PG8_WAIT_L
#undef PG8_BAR
#undef PG8_SCHED
}

struct EpiBf16 {
    static constexpr bool PERM = true;
    bf16_t* O; int ldc;
    __device__ __forceinline__ void operator()(const f32x4 (&acc)[2][2][4][2], const Unit& u, int wr, int wc, int fr, int fq) const {
        const int row0 = u.pm * BM + wr * 64 + fr, col0 = u.pn * BM + wc * 32 + 8 * fq;
#pragma unroll
        for (int ai = 0; ai < 2; ++ai)
#pragma unroll
            for (int m = 0; m < 4; ++m) { bf16_t* rowp = O + (size_t)(row0 + ai * HALF + m * 16) * ldc + col0;
#pragma unroll
                for (int bj = 0; bj < 2; ++bj) { const f32x4 v0 = acc[ai][bj][m][0], v1 = acc[ai][bj][m][1];
                    u32x4 w; w.x = pk_bf16(v0[0], v0[1]); w.y = pk_bf16(v0[2], v0[3]); w.z = pk_bf16(v1[0], v1[1]); w.w = pk_bf16(v1[2], v1[3]);
                    *(u32x4*)(rowp + bj * HALF) = w; } }
    }
};
struct EpiSwiGLU {
    static constexpr bool PERM = true;
    bf16_t* O; int ldc;
    __device__ __forceinline__ void operator()(const f32x4 (&acc)[2][2][4][2], const Unit& u, int wr, int wc, int fr, int fq) const {
        const int row0 = u.pm * BM + wr * 64 + fr, col0 = u.pn * HALF + wc * 32 + 8 * fq;
#pragma unroll
        for (int ai = 0; ai < 2; ++ai)
#pragma unroll
            for (int m = 0; m < 4; ++m) { bf16_t* rowp = O + (size_t)(row0 + ai * HALF + m * 16) * ldc + col0;
                const f32x4 g0 = acc[ai][0][m][0], g1 = acc[ai][0][m][1], u0 = acc[ai][1][m][0], u1 = acc[ai][1][m][1];
                float r[8];
#pragma unroll
                for (int j = 0; j < 4; ++j) { r[j] = siluf_(g0[j]) * u0[j]; r[4 + j] = siluf_(g1[j]) * u1[j]; }
                u32x4 w; w.x = pk_bf16(r[0], r[1]); w.y = pk_bf16(r[2], r[3]); w.z = pk_bf16(r[4], r[5]); w.w = pk_bf16(r[6], r[7]);
                *(u32x4*)rowp = w; }
    }
};
struct EpiMerge {
    static constexpr bool PERM = false;
    const bf16_t* Y; bf16_t* O;
    __device__ __forceinline__ void operator()(const f32x4 (&acc)[2][2][4][2], const Unit& u, int wr, int wc, int fr, int fq) const {
        const int row0 = u.pm * BM + wr * 64 + fr, c0 = u.pn * 64 + wc * 16 + 4 * fq;
#pragma unroll
        for (int ai = 0; ai < 2; ++ai)
#pragma unroll
            for (int m = 0; m < 4; ++m) { const size_t row = (size_t)(row0 + ai * HALF + m * 16);
                float s[4] = {0.f, 0.f, 0.f, 0.f};
#pragma unroll
                for (int bj = 0; bj < 2; ++bj)
#pragma unroll
                    for (int n = 0; n < 2; ++n) { const u32x2 y = *(const u32x2*)(Y + row * 4096 + (2 * bj + n) * 1024 + c0); const f32x4 a = acc[ai][bj][m][n];
                        s[0] += sigmoidf_(a[0]) * bf_lo(y.x); s[1] += sigmoidf_(a[1]) * bf_hi(y.x); s[2] += sigmoidf_(a[2]) * bf_lo(y.y); s[3] += sigmoidf_(a[3]) * bf_hi(y.y); }
                u32x2 w; w.x = pk_bf16(s[0], s[1]); w.y = pk_bf16(s[2], s[3]);
                *(u32x2*)(O + row * 1024 + c0) = w; }
    }
};
}

__device__ __forceinline__ int srccol(int kind, int n) {
    if (kind == 0) { const int pn = n >> 8, w = n & 255; return w < 128 ? pn * 128 + w : DFF + pn * 128 + (w - 128); }
    if (kind == 1) return n;
    if (kind == 2) return n < NNG ? n : -1;
    const int pn = n >> 8, T = n & 255, bj = T >> 7, wc = (T >> 5) & 3, nn = (T >> 4) & 1, fq = (T >> 2) & 3, j = T & 3;
    return NNG + (2 * bj + nn) * 1024 + 64 * pn + 16 * wc + 4 * fq + j;
}
__device__ void prep_weights(const KArgs& a, int l, float* tile) {
    unsigned char* ws = a.ws; const int tid = tidx();
    for (int tix = bidx(); tix < 6720; tix += gdim()) {
        int tl = tix, kind, K, ld, NT; const float* src; bf16_t* dst;
        if (tl < 1408) { kind = 0; src = a.in[4] + (size_t)l * 1024 * 5632; dst = (bf16_t*)(ws + WS_GU1); K = 1024; ld = 5632; NT = 88; }
        else if ((tl -= 1408) < 704) { kind = 1; src = a.in[5] + (size_t)l * DFF * 1024; dst = (bf16_t*)(ws + WS_DN1); K = DFF; ld = 1024; NT = 16; }
        else if ((tl -= 704) < 960) { kind = 2; src = a.in[8] + (size_t)l * 1024 * NIN; dst = (bf16_t*)(ws + WS_INT); K = 1024; ld = NIN; NT = 60; }
        else if ((tl -= 960) < 1024) { kind = 3; src = a.in[8] + (size_t)l * 1024 * NIN; dst = (bf16_t*)(ws + WS_GT); K = 1024; ld = NIN; NT = 64; }
        else if ((tl -= 1024) < 256) { kind = 1; const int nb = tl >> 6; tl &= 63; src = a.in[30] + (size_t)(l * 4 + nb) * 256 * 1024; dst = (bf16_t*)(ws + WS_BR) + (size_t)nb * 1024 * 256; K = 256; ld = 1024; NT = 16; }
        else if ((tl -= 256) < 256) { kind = 1; src = a.in[31] + (size_t)l * 1024 * 1024; dst = (bf16_t*)(ws + WS_OUT); K = 1024; ld = 1024; NT = 16; }
        else if ((tl -= 256) < 1408) { kind = 0; src = a.in[34] + (size_t)l * 1024 * 5632; dst = (bf16_t*)(ws + WS_GU2); K = 1024; ld = 5632; NT = 88; }
        else { tl -= 1408; kind = 1; src = a.in[35] + (size_t)l * DFF * 1024; dst = (bf16_t*)(ws + WS_DN2); K = DFF; ld = 1024; NT = 16; }
        const int tn = tl % NT, tk = tl / NT, n0 = tn * 64, k0 = tk * 64;
        const int cidx = tid & 63, r = tid >> 6;
        const int sc = srccol(kind, n0 + cidx);
#pragma unroll
        for (int rr = 0; rr < 8; ++rr) { const int kl = rr * 8 + r; tile[kl * 65 + cidx] = sc >= 0 ? src[(size_t)(k0 + kl) * ld + sc] : 0.f; }
        __syncthreads();
#pragma unroll
        for (int rr = 0; rr < 8; ++rr) { const int nl = rr * 8 + r; dst[(size_t)(n0 + nl) * K + k0 + cidx] = f2bf(tile[cidx * 65 + nl]); }
        __syncthreads();
    }
}
__device__ void filter_hidden(const KArgs& a, int l, float* h1s) {
    const int tid = tidx(), p = tid >> 6, u = tid & 63;
    const float* w1 = a.in[11] + (size_t)l * 33 * 64; const float* b1 = a.in[12] + l * 64; const float* w2 = a.in[13] + (size_t)l * 64 * 64; const float* b2 = a.in[14] + l * 64;
    const float* fr = a.in[15] + (size_t)l * 128;
    float* H2 = (float*)(a.ws + WS_H2);
    for (int pb = bidx(); pb < 1024; pb += gdim()) {
        const int t = pb * 8 + p; const float tp = (float)t * (1.0f / 8191.0f);
        float acc = b1[u] + tp * w1[u];
#pragma unroll
        for (int j = 0; j < 16; ++j) { const float band = 1e-4f + (float)j * ((15.0f - 1e-4f) / 15.0f);
            float rev = (band * (float)t) * (1.0f / 8192.0f); rev -= floorf(rev);
            const float c = __builtin_amdgcn_cosf(rev), s = __builtin_amdgcn_sinf(rev);
            acc += c * w1[(1 + j) * 64 + u] - s * w1[(17 + j) * 64 + u]; }
        h1s[p * 64 + u] = sin_rad(fr[u] * acc);
        __syncthreads();
        float acc2 = b2[u];
#pragma unroll 8
        for (int k = 0; k < 64; ++k) acc2 += h1s[p * 64 + k] * w2[k * 64 + u];
        H2[(size_t)t * 64 + u] = sin_rad(fr[64 + u] * acc2);
        __syncthreads();
    }
}

__device__ __forceinline__ void fft_fwd(float2* X, int tid) {
#pragma unroll 1
    for (int h = FN / 2; h >= 1; h >>= 1) {
        const float inv2h = 0.5f / (float)h;
#pragma unroll 2
        for (int b = tid; b < FN / 2; b += 512) {
            const int j = b & (h - 1), i = ((b - j) << 1) + j;
            const float2 x0 = X[i], x1 = X[i + h];
            const float f = -(float)j * inv2h;
            const float cw = __builtin_amdgcn_cosf(f), sw = __builtin_amdgcn_sinf(f);
            const float dx = x0.x - x1.x, dy = x0.y - x1.y;
            X[i] = make_float2(x0.x + x1.x, x0.y + x1.y);
            X[i + h] = make_float2(dx * cw - dy * sw, dx * sw + dy * cw);
        }
        __syncthreads();
    }
}
__device__ __forceinline__ void fft_inv(float2* X, int tid) {
#pragma unroll 1
    for (int h = 1; h <= FN / 2; h <<= 1) {
        const float inv2h = 0.5f / (float)h;
#pragma unroll 2
        for (int b = tid; b < FN / 2; b += 512) {
            const int j = b & (h - 1), i = ((b - j) << 1) + j;
            const float2 x0 = X[i], x1 = X[i + h];
            const float f = (float)j * inv2h;
            const float cw = __builtin_amdgcn_cosf(f), sw = __builtin_amdgcn_sinf(f);
            const float cx = x1.x * cw - x1.y * sw, cy = x1.x * sw + x1.y * cw;
            X[i] = make_float2(x0.x + cx, x0.y + cy);
            X[i + h] = make_float2(x0.x - cx, x0.y - cy);
        }
        __syncthreads();
    }
}
__device__ __forceinline__ int brev14(int k) { return (int)(__brev((unsigned)k) >> 18); }

__device__ void filter_spectra(const KArgs& a, int l, float2* X, float* w3s) {
    const int tid = tidx();
    const float* H2 = (const float*)(a.ws + WS_H2);
    float4* SP = (float4*)(a.ws + WS_SP);
    const float* w3 = a.in[16] + (size_t)l * 64 * 1024; const float* dec = a.in[17] + (size_t)l * 1024;
    for (int item = bidx(); item < 256; item += gdim()) {
        const int o = item >> 7, cp = item & 127, c = 2 * cp;
        if (tid < 256) { const int k = tid >> 2, q = tid & 3; w3s[k * 4 + q] = w3[(size_t)k * 1024 + o * 512 + (q >> 1) * 256 + c + (q & 1)]; }
        const float dc0 = fabsf(dec[o * 512 + c]), dc1 = fabsf(dec[o * 512 + c + 1]), dc2 = fabsf(dec[o * 512 + 256 + c]), dc3 = fabsf(dec[o * 512 + 256 + c + 1]);
        __syncthreads();
#pragma unroll 1
        for (int i = 0; i < 16; ++i) {
            const int t = tid + 512 * i;
            const float4* hrow = (const float4*)(H2 + (size_t)t * 64);
            float d0 = 0.f, d1 = 0.f, d2 = 0.f, d3 = 0.f;
#pragma unroll 2
            for (int k4 = 0; k4 < 16; ++k4) { const float4 hv = hrow[k4]; const float hh[4] = {hv.x, hv.y, hv.z, hv.w};
#pragma unroll
                for (int kk = 0; kk < 4; ++kk) { const float4 w = *(const float4*)(w3s + (k4 * 4 + kk) * 4); d0 += hh[kk] * w.x; d1 += hh[kk] * w.y; d2 += hh[kk] * w.z; d3 += hh[kk] * w.w; } }
            const float tp = (float)t * (1.0f / 8191.0f);
            X[t] = make_float2(d0 * __expf(-tp * dc0), d1 * __expf(-tp * dc1));
            if (t >= 1) X[FN - t] = make_float2(d2 * __expf(-tp * dc2), d3 * __expf(-tp * dc3)); else X[FN / 2] = make_float2(0.f, 0.f);
        }
        __syncthreads();
        fft_fwd(X, tid);
        const float sc = 1.0f / (float)FN;
#pragma unroll 2
        for (int j = 0; j < 16; ++j) {
            const int s = tid + 512 * j, p = 2 * s, k = brev14(p), p2 = brev14((FN - k) & (FN - 1));
            const float2 G1 = X[p], G2 = X[p2];
            SP[(size_t)item * SPP + s] = make_float4(0.5f * sc * (G1.x + G2.x), 0.5f * sc * (G1.y - G2.y), 0.5f * sc * (G1.y + G2.y), -0.5f * sc * (G1.x - G2.x));
        }
        if (tid == 0) { const float2 G1 = X[1]; SP[(size_t)item * SPP + 8192] = make_float4(sc * G1.x, 0.f, sc * G1.y, 0.f); }
        __syncthreads();
    }
}
__device__ __forceinline__ void spec_mul(float2* X, const float4* sp, int tid) {
#pragma unroll 2
    for (int j = 0; j < 16; ++j) {
        const int s = tid + 512 * j, p = 2 * s, k = brev14(p), p2 = brev14((FN - k) & (FN - 1));
        const float4 g = sp[s];
        const float2 Z1 = X[p], Z2 = X[p2];
        const float ax = 0.5f * (Z1.x + Z2.x), ay = 0.5f * (Z1.y - Z2.y), bx = 0.5f * (Z1.y + Z2.y), by = -0.5f * (Z1.x - Z2.x);
        const float agx = ax * g.x - ay * g.y, agy = ax * g.y + ay * g.x, bgx = bx * g.z - by * g.w, bgy = bx * g.w + by * g.z;
        X[p2] = make_float2(agx + bgy, -agy + bgx);
        X[p] = make_float2(agx - bgy, agy + bgx);
    }
    if (tid == 0) { const float4 g = sp[8192]; const float2 Z1 = X[1]; X[1] = make_float2(Z1.x * g.x, Z1.y * g.z); }
    __syncthreads();
}
__device__ __forceinline__ float2 conv_pair(const bf16_t* pr, int t, int col, const float* cw, const float* cb) {
    asm volatile("" : "+v"(t));
    const unsigned* p0 = (const unsigned*)(pr + (size_t)t * NPROJ + col);
    const unsigned m0 = *p0;
    unsigned mm = *(t >= 1 ? p0 - NPROJ / 2 : p0);
    unsigned mp = *(t + 1 < SEQ ? p0 + NPROJ / 2 : p0);
    mm = t >= 1 ? mm : 0u; mp = t + 1 < SEQ ? mp : 0u;
    float2 r;
    r.x = cb[col] + cw[col] * bf_lo(mm) + cw[768 + col] * bf_lo(m0) + cw[1536 + col] * bf_lo(mp);
    r.y = cb[col + 1] + cw[col + 1] * bf_hi(mm) + cw[768 + col + 1] * bf_hi(m0) + cw[1536 + col + 1] * bf_hi(mp);
    return r;
}
__device__ void hyena_phase(const KArgs& a, int l, float2* X) {
    const int tid = tidx();
    const bf16_t* proj = (const bf16_t*)(a.ws + WS_PROJ); bf16_t* ys = (bf16_t*)(a.ws + WS_YS);
    const float4* SP = (const float4*)(a.ws + WS_SP);
    const float* cw = a.in[9] + (size_t)l * 3 * 768; const float* cb = a.in[10] + (size_t)l * 768; const float* hb = a.in[18] + (size_t)l * 512;
    for (int item = bidx(); item < GS * 128; item += gdim()) {
        const int s = item >> 7, cp = item & 127, c = 2 * cp;
        const bf16_t* pr = proj + (size_t)s * SEQ * NPROJ;
        float2 vreg[16], zreg[16];
#pragma unroll
        for (int i = 0; i < 16; ++i) { const int t = tid + 512 * i; vreg[i] = conv_pair(pr, t, c, cw, cb); X[t] = vreg[i]; X[t + SEQ] = make_float2(0.f, 0.f); if ((i & 3) == 3) __builtin_amdgcn_sched_barrier(0); }
        __syncthreads();
        fft_fwd(X, tid); spec_mul(X, SP + (size_t)cp * SPP, tid); fft_inv(X, tid);
        const float b00 = hb[c], b01 = hb[c + 1], b10 = hb[256 + c], b11 = hb[256 + c + 1];
#pragma unroll
        for (int i = 0; i < 16; ++i) { const int t = tid + 512 * i; const float2 y = X[t]; const float2 x1 = conv_pair(pr, t, 256 + c, cw, cb);
            zreg[i] = make_float2(x1.x * (y.x + b00 * vreg[i].x), x1.y * (y.y + b01 * vreg[i].y)); if ((i & 3) == 3) __builtin_amdgcn_sched_barrier(0); }
        __syncthreads();
#pragma unroll
        for (int i = 0; i < 16; ++i) { const int t = tid + 512 * i; X[t] = zreg[i]; X[t + SEQ] = make_float2(0.f, 0.f); }
        __syncthreads();
        fft_fwd(X, tid); spec_mul(X, SP + (size_t)(128 + cp) * SPP, tid); fft_inv(X, tid);
#pragma unroll
        for (int i = 0; i < 16; ++i) { const int t = tid + 512 * i; const float2 y = X[t]; const float2 x2 = conv_pair(pr, t, 512 + c, cw, cb);
            *(unsigned*)(ys + (size_t)(s * SEQ + t) * 1024 + c) = pk_bf16(x2.x * (y.x + b10 * zreg[i].x), x2.y * (y.y + b11 * zreg[i].y)); if ((i & 3) == 3) __builtin_amdgcn_sched_barrier(0); }
        __syncthreads();
    }
}

__device__ void norm_rows(const float* xsrc, float* xdst, const bf16_t* tmp, const float* w_post, float scale, const float* w_pre, bf16_t* xn) {
    const int wave = tidx() >> 6, lane = tidx() & 63;
    for (int r = bidx() * 8 + wave; r < MG; r += gdim() * 8) {
        float x[16];
#pragma unroll
        for (int hh = 0; hh < 2; ++hh) { const float4* p = (const float4*)(xsrc + (size_t)r * 1024 + hh * 512 + lane * 8); const float4 v0 = p[0], v1 = p[1];
            x[hh * 8 + 0] = v0.x; x[hh * 8 + 1] = v0.y; x[hh * 8 + 2] = v0.z; x[hh * 8 + 3] = v0.w; x[hh * 8 + 4] = v1.x; x[hh * 8 + 5] = v1.y; x[hh * 8 + 6] = v1.z; x[hh * 8 + 7] = v1.w; }
        if (tmp) {
            float tv[16]; float ss = 0.f;
#pragma unroll
            for (int hh = 0; hh < 2; ++hh) { const u32x4 w = *(const u32x4*)(tmp + (size_t)r * 1024 + hh * 512 + lane * 8);
                tv[hh * 8 + 0] = bf_lo(w.x); tv[hh * 8 + 1] = bf_hi(w.x); tv[hh * 8 + 2] = bf_lo(w.y); tv[hh * 8 + 3] = bf_hi(w.y); tv[hh * 8 + 4] = bf_lo(w.z); tv[hh * 8 + 5] = bf_hi(w.z); tv[hh * 8 + 6] = bf_lo(w.w); tv[hh * 8 + 7] = bf_hi(w.w); }
#pragma unroll
            for (int i = 0; i < 16; ++i) ss += tv[i] * tv[i];
            ss = wave_sum(ss);
            const float rs = scale * rsqrtf(ss * (1.0f / 1024.0f) + EPS);
#pragma unroll
            for (int hh = 0; hh < 2; ++hh) { const float4* wp = (const float4*)(w_post + hh * 512 + lane * 8); const float4 w0 = wp[0], w1 = wp[1];
                const float ww[8] = {w0.x, w0.y, w0.z, w0.w, w1.x, w1.y, w1.z, w1.w};
#pragma unroll
                for (int i = 0; i < 8; ++i) x[hh * 8 + i] += tv[hh * 8 + i] * rs * ww[i]; }
        }
        if (xdst) {
#pragma unroll
            for (int hh = 0; hh < 2; ++hh) { float4* p = (float4*)(xdst + (size_t)r * 1024 + hh * 512 + lane * 8);
                p[0] = make_float4(x[hh * 8 + 0], x[hh * 8 + 1], x[hh * 8 + 2], x[hh * 8 + 3]); p[1] = make_float4(x[hh * 8 + 4], x[hh * 8 + 5], x[hh * 8 + 6], x[hh * 8 + 7]); }
        }
        if (xn) {
            float ss = 0.f;
#pragma unroll
            for (int i = 0; i < 16; ++i) ss += x[i] * x[i];
            ss = wave_sum(ss);
            const float rs = rsqrtf(ss * (1.0f / 1024.0f) + EPS);
#pragma unroll
            for (int hh = 0; hh < 2; ++hh) { const float4* wp = (const float4*)(w_pre + hh * 512 + lane * 8); const float4 w0 = wp[0], w1 = wp[1];
                const float ww[8] = {w0.x, w0.y, w0.z, w0.w, w1.x, w1.y, w1.z, w1.w};
                u32x4 o; o.x = pk_bf16(x[hh * 8 + 0] * rs * ww[0], x[hh * 8 + 1] * rs * ww[1]); o.y = pk_bf16(x[hh * 8 + 2] * rs * ww[2], x[hh * 8 + 3] * rs * ww[3]);
                o.z = pk_bf16(x[hh * 8 + 4] * rs * ww[4], x[hh * 8 + 5] * rs * ww[5]); o.w = pk_bf16(x[hh * 8 + 6] * rs * ww[6], x[hh * 8 + 7] * rs * ww[7]);
                *(u32x4*)(xn + (size_t)r * 1024 + hh * 512 + lane * 8) = o; }
        }
    }
}

__device__ __forceinline__ void unpack8(const u32x4 w, float (&f)[8]) { f[0] = bf_lo(w.x); f[1] = bf_hi(w.x); f[2] = bf_lo(w.y); f[3] = bf_hi(w.y); f[4] = bf_lo(w.z); f[5] = bf_hi(w.z); f[6] = bf_lo(w.w); f[7] = bf_hi(w.w); }
__device__ __forceinline__ u32x4 pack8(const float (&f)[8]) { u32x4 w; w.x = pk_bf16(f[0], f[1]); w.y = pk_bf16(f[2], f[3]); w.z = pk_bf16(f[4], f[5]); w.w = pk_bf16(f[6], f[7]); return w; }
__device__ void prescan_phase(const KArgs& a, int l) {
    const bf16_t* proj = (const bf16_t*)(a.ws + WS_PROJ); bf16_t* sc = (bf16_t*)(a.ws + WS_SC); float* dta = (float*)(a.ws + WS_DTA);
    const float* mcw = a.in[19] + (size_t)l * 3 * 512; const float* mcb = a.in[20] + (size_t)l * 512;
    const float* dtb = a.in[21] + l * 8; const float* alog = a.in[22] + l * 8;
    const float* wg2 = a.in[25] + (size_t)l * 2 * 16 * 128; const float* bg = a.in[26] + (size_t)l * 256;
    const float* lbp = a.in[28];
    const int total = MG * 161;
    for (int idx = bidx() * 512 + tidx(); idx < total; idx += gdim() * 512) {
        const int tok = idx / 161, ch = idx - tok * 161, t = tok & (SEQ - 1);
        const bf16_t* row = proj + (size_t)tok * NPROJ;
        if (ch < 64) {
            const int c0 = ch * 8; float x0[8], xm[8], xp[8], o[8];
            unpack8(*(const u32x4*)(row + C_XBC + c0), x0);
            if (t >= 1) unpack8(*(const u32x4*)(row - NPROJ + C_XBC + c0), xm); else { for (int i = 0; i < 8; ++i) xm[i] = 0.f; }
            if (t + 1 < SEQ) unpack8(*(const u32x4*)(row + NPROJ + C_XBC + c0), xp); else { for (int i = 0; i < 8; ++i) xp[i] = 0.f; }
#pragma unroll
            for (int i = 0; i < 8; ++i) o[i] = siluf_(mcb[c0 + i] + mcw[c0 + i] * xm[i] + mcw[512 + c0 + i] * x0[i] + mcw[1024 + c0 + i] * xp[i]);
            *(u32x4*)(sc + (size_t)tok * SCW + c0) = pack8(o);
        } else if (ch == 64) {
            float z[8]; unpack8(*(const u32x4*)(row + C_DT), z);
            float dt[8], av[8];
#pragma unroll
            for (int i = 0; i < 8; ++i) { dt[i] = softplusf_(z[i] + dtb[i]); av[i] = __expf(-dt[i] * __expf(alog[i])); }
            float4* d = (float4*)(dta + (size_t)tok * 16);
            d[0] = make_float4(dt[0], dt[1], dt[2], dt[3]); d[1] = make_float4(dt[4], dt[5], dt[6], dt[7]);
            d[2] = make_float4(av[0], av[1], av[2], av[3]); d[3] = make_float4(av[4], av[5], av[6], av[7]);
        } else if (ch < 97) {
            const int gc = ch - 65, dir = gc >> 4, k0 = (gc & 15) * 8;
            float ga[16];
            { float t8[8]; unpack8(*(const u32x4*)(row + C_GA + dir * 16), t8); for (int i = 0; i < 8; ++i) ga[i] = t8[i];
              unpack8(*(const u32x4*)(row + C_GA + dir * 16 + 8), t8); for (int i = 0; i < 8; ++i) ga[8 + i] = t8[i]; }
            float o[8];
#pragma unroll
            for (int i = 0; i < 8; ++i) o[i] = bg[dir * 128 + k0 + i];
#pragma unroll
            for (int r = 0; r < 16; ++r) { const float4* wp = (const float4*)(wg2 + (size_t)(dir * 16 + r) * 128 + k0); const float4 w0 = wp[0], w1 = wp[1];
                o[0] += ga[r] * w0.x; o[1] += ga[r] * w0.y; o[2] += ga[r] * w0.z; o[3] += ga[r] * w0.w; o[4] += ga[r] * w1.x; o[5] += ga[r] * w1.y; o[6] += ga[r] * w1.z; o[7] += ga[r] * w1.w; }
#pragma unroll
            for (int i = 0; i < 8; ++i) { const float ls = -softplusf_(-o[i]); o[i] = 1.0f - __expf(ls * (1.0f / 16.0f)); }
            *(u32x4*)(sc + (size_t)tok * SCW + 512 + dir * 128 + k0) = pack8(o);
        } else {
            const int hc = ch - 97, dir = hc >> 5, i0 = (hc & 31) * 8;
            float z[8], o[8]; unpack8(*(const u32x4*)(row + C_HF + hc * 8), z);
#pragma unroll
            for (int i = 0; i < 8; ++i) { float lb = 0.f;
                if (l > 0) { const float p0 = lbp[dir * 256 + i0 + i], p1 = lbp[512 + dir * 256 + i0 + i]; lb = sigmoidf_(p1 - p0); }
                o[i] = (1.0f - lb) * __builtin_amdgcn_rcpf(1.0f + __expf(z[i])); }
            *(u32x4*)(sc + (size_t)tok * SCW + 768 + hc * 8) = pack8(o);
        }
    }
}

template <int MODE>
__device__ __forceinline__ void scan_chain(const bf16_t* qp, const bf16_t* kp, const bf16_t* vp, const bf16_t* ap, const float* dp,
                                           bf16_t* op, int pq, int pk, int pv, int pa, int dir, int lane) {
    constexpr int DPL = MODE == 0 ? 2 : 4;
    constexpr int U = 8;
    float S[DPL];
#pragma unroll
    for (int i = 0; i < DPL; ++i) S[i] = 0.f;
    unsigned Q0[2][U], Q1[2][U], K0[2][U], K1[2][U], A0[2][U]; unsigned short V[2][U]; float DT[2][U], AS[2][U];
#define SC_LOAD(bi, base) do { _Pragma("unroll") for (int u = 0; u < U; ++u) { const int st = (base) + u; const size_t tt = (size_t)(dir ? (SEQ - 1 - st) : st); \
        if (DPL == 4) { const u32x2 q = *(const u32x2*)(qp + tt * pq); Q0[bi][u] = q.x; Q1[bi][u] = q.y; const u32x2 k = *(const u32x2*)(kp + tt * pk); K0[bi][u] = k.x; K1[bi][u] = k.y; } \
        else { Q0[bi][u] = *(const unsigned*)(qp + tt * pq); K0[bi][u] = *(const unsigned*)(kp + tt * pk); A0[bi][u] = *(const unsigned*)(ap + tt * pa); } \
        V[bi][u] = vp[tt * pv]; \
        if (MODE == 2) { DT[bi][u] = dp[tt * 16]; AS[bi][u] = dp[tt * 16 + 8]; } } } while (0)
#define SC_COMP(bi, base) do { _Pragma("unroll") for (int u = 0; u < U; ++u) { const int st = (base) + u; const size_t tt = (size_t)(dir ? (SEQ - 1 - st) : st); \
        float v = bf2f(V[bi][u]); float o; \
        if (MODE == 0) { const float q0 = bf_lo(Q0[bi][u]), q1 = bf_hi(Q0[bi][u]), k0 = bf_lo(K0[bi][u]), k1 = bf_hi(K0[bi][u]), m0 = bf_lo(A0[bi][u]), m1 = bf_hi(A0[bi][u]); \
            S[0] = (S[0] - m0 * S[0]) + k0 * v; S[1] = (S[1] - m1 * S[1]) + k1 * v; o = S[0] * q0 + S[1] * q1; } \
        else { const float q0 = bf_lo(Q0[bi][u]), q1 = bf_hi(Q0[bi][u]), q2 = bf_lo(Q1[bi][u]), q3 = bf_hi(Q1[bi][u]); \
            const float k0 = bf_lo(K0[bi][u]), k1 = bf_hi(K0[bi][u]), k2 = bf_lo(K1[bi][u]), k3 = bf_hi(K1[bi][u]); \
            if (MODE == 1) { S[0] += k0 * (v - S[0]); S[1] += k1 * (v - S[1]); S[2] += k2 * (v - S[2]); S[3] += k3 * (v - S[3]); } \
            else { v *= DT[bi][u]; const float aa = AS[bi][u]; S[0] = aa * S[0] + k0 * v; S[1] = aa * S[1] + k1 * v; S[2] = aa * S[2] + k2 * v; S[3] = aa * S[3] + k3 * v; } \
            o = (S[0] * q0 + S[1] * q1) + (S[2] * q2 + S[3] * q3); } \
        o += __shfl_xor(o, 4); o += __shfl_xor(o, 8); o += __shfl_xor(o, 16); o += __shfl_xor(o, 32); \
        if (lane < 4) op[tt * 768] = f2bf(o); } } while (0)
    SC_LOAD(0, 0);
    for (int b = 0; b < SEQ; b += 2 * U) {
        SC_LOAD(1, b + U);
        SC_COMP(0, b);
        if (b + 2 * U < SEQ) SC_LOAD(0, b + 2 * U);
        SC_COMP(1, b + U);
    }
#undef SC_LOAD
#undef SC_COMP
}
__device__ void scan_phase(const KArgs& a) {
    const bf16_t* proj = (const bf16_t*)(a.ws + WS_PROJ); const bf16_t* sc = (const bf16_t*)(a.ws + WS_SC); const float* dta = (const float*)(a.ws + WS_DTA);
    bf16_t* so = (bf16_t*)(a.ws + WS_SO);
    const int wave = tidx() >> 6, lane = tidx() & 63, esub = lane & 3, dgrp = lane >> 2;
    for (int item = wave * gdim() + bidx(); item < GS * 3 * 4 * 2 * 16; item += 8 * gdim()) {
        const int sp = item & 15, dir = (item >> 4) & 1, h = (item >> 5) & 3, s = (item >> 7) % GS, br = (item >> 7) / GS;
        const size_t t0 = (size_t)s * SEQ;
        const int e = sp * 4 + esub;
        bf16_t* op = so + ((size_t)dir * MG + t0) * 768 + br * 256 + h * 64 + e;
        if (br == 0) {
            const int grp = h >> 1;
            scan_chain<2>(sc + t0 * SCW + 384 + grp * 64 + dgrp * 4, sc + t0 * SCW + 256 + grp * 64 + dgrp * 4, sc + t0 * SCW + h * 64 + e, nullptr,
                          dta + t0 * 16 + dir * 4 + h, op, SCW, SCW, SCW, 0, dir, lane);
        } else if (br == 1) {
            scan_chain<0>(proj + t0 * NPROJ + C_GQ + h * 32 + dgrp * 2, proj + t0 * NPROJ + C_GK + h * 32 + dgrp * 2, proj + t0 * NPROJ + C_GV + h * 64 + e,
                          sc + t0 * SCW + 512 + dir * 128 + h * 32 + dgrp * 2, nullptr, op, NPROJ, NPROJ, NPROJ, SCW, dir, lane);
        } else {
            scan_chain<1>(proj + t0 * NPROJ + C_HQ + h * 64 + dgrp * 4, sc + t0 * SCW + 768 + dir * 256 + h * 64 + dgrp * 4, proj + t0 * NPROJ + C_HI + h * 64 + e,
                          nullptr, nullptr, op, NPROJ, SCW, NPROJ, 0, dir, lane);
        }
    }
}

__device__ __forceinline__ void ld4(const bf16_t* p, float (&f)[4]) { const u32x2 w = *(const u32x2*)p; f[0] = bf_lo(w.x); f[1] = bf_hi(w.x); f[2] = bf_lo(w.y); f[3] = bf_hi(w.y); }
__device__ __forceinline__ void st4(bf16_t* p, const float (&f)[4]) { u32x2 w; w.x = pk_bf16(f[0], f[1]); w.y = pk_bf16(f[2], f[3]); *(u32x2*)p = w; }
__device__ void postscan_phase(const KArgs& a, int l) {
    const bf16_t* proj = (const bf16_t*)(a.ws + WS_PROJ); const bf16_t* sc = (const bf16_t*)(a.ws + WS_SC); const bf16_t* so = (const bf16_t*)(a.ws + WS_SO);
    bf16_t* ys = (bf16_t*)(a.ws + WS_YS);
    const float* mD = a.in[23] + l * 4; const float* mN = a.in[24] + l * 256; const float* gN = a.in[27] + l * 64; const float* hN = a.in[29] + l * 64;
    const int wave = tidx() >> 6, lane = tidx() & 63, c4 = lane * 4;
    for (int tok = bidx() * 8 + wave; tok < MG; tok += gdim() * 8) {
        const bf16_t* sf = so + (size_t)tok * 768; const bf16_t* sb = so + ((size_t)MG + tok) * 768; const bf16_t* row = proj + (size_t)tok * NPROJ;
        float of[4], ob[4], g[4], y[4];
        {
            float mx[4]; ld4(sf + c4, of); ld4(sb + c4, ob); ld4(sc + (size_t)tok * SCW + c4, mx); ld4(row + C_M2Z + c4, g);
            const float Dh = mD[lane >> 4]; float ss = 0.f;
#pragma unroll
            for (int j = 0; j < 4; ++j) { y[j] = (of[j] + ob[j] + Dh * mx[j]) * siluf_(g[j]); ss += y[j] * y[j]; }
            ss = wave_sum(ss); const float rs = rsqrtf(ss * (1.0f / 256.0f) + EPS);
#pragma unroll
            for (int j = 0; j < 4; ++j) y[j] *= rs * mN[c4 + j];
            st4(ys + (size_t)tok * 1024 + 256 + c4, y);
        }
        {
            ld4(sf + 256 + c4, of); ld4(sb + 256 + c4, ob); ld4(row + C_GG + c4, g); float ss = 0.f;
#pragma unroll
            for (int j = 0; j < 4; ++j) { y[j] = (of[j] + ob[j]) * 0.17677669529663687f; ss += y[j] * y[j]; }
            ss += __shfl_xor(ss, 1); ss += __shfl_xor(ss, 2); ss += __shfl_xor(ss, 4); ss += __shfl_xor(ss, 8);
            const float rs = rsqrtf(ss * (1.0f / 64.0f) + EPS);
#pragma unroll
            for (int j = 0; j < 4; ++j) y[j] = y[j] * rs * gN[(c4 & 63) + j] * siluf_(g[j]);
            st4(ys + (size_t)tok * 1024 + 512 + c4, y);
        }
        {
            ld4(sf + 512 + c4, of); ld4(sb + 512 + c4, ob); ld4(row + C_HGG + c4, g); float ss = 0.f;
#pragma unroll
            for (int j = 0; j < 4; ++j) { y[j] = (of[j] + ob[j]) * 0.125f; ss += y[j] * y[j]; }
            ss += __shfl_xor(ss, 1); ss += __shfl_xor(ss, 2); ss += __shfl_xor(ss, 4); ss += __shfl_xor(ss, 8);
            const float rs = rsqrtf(ss * (1.0f / 64.0f) + EPS);
#pragma unroll
            for (int j = 0; j < 4; ++j) y[j] = y[j] * rs * hN[(c4 & 63) + j] * siluf_(g[j]);
            st4(ys + (size_t)tok * 1024 + 768 + c4, y);
        }
    }
}

__global__ void __launch_bounds__(512) hybrid_fwd(KArgs a) {
    extern __shared__ __attribute__((aligned(16))) unsigned char lds_raw[];
    LAS unsigned char* lds = (LAS unsigned char*)lds_raw;
    cg::grid_group grid = cg::this_grid();
    unsigned char* ws = a.ws;
    const int lo = a.ph_lo, hi = a.ph_hi;
    const int G = gdim(), bid = bidx();
#pragma unroll 1
    for (int pc = lo; pc < hi; ++pc) {
        const int l = pc / 50, r = pc - l * 50;
        bf16_t* XN = (bf16_t*)(ws + WS_XN); bf16_t* PROJ = (bf16_t*)(ws + WS_PROJ); bf16_t* ACT = PROJ; bf16_t* YB = PROJ;
        bf16_t* YS = (bf16_t*)(ws + WS_YS); bf16_t* TMP = (bf16_t*)(ws + WS_TMP); bf16_t* MERGED = (bf16_t*)(ws + WS_SO);
        if (r == 0) { prep_weights(a, l, (float*)lds_raw); filter_hidden(a, l, (float*)lds_raw); }
        else if (r == 1) { filter_spectra(a, l, (float2*)lds_raw, (float*)(lds_raw + 131072)); }
        else {
            const int g = (r - 2) >> 4, j = (r - 2) & 15;
            float* xg = a.out + (size_t)g * MG * 1024;
            if (j == 0 || j == 3 || j == 12 || j == 15) {
                const float* xsrc = xg; float* xdst = xg; const bf16_t* tmp = TMP; const float* wpost = nullptr; const float* wpre = nullptr; float scale = 0.5f; bf16_t* xn = XN;
                if (j == 0) { xsrc = (l == 0) ? ((g < 2) ? a.in[0] + (size_t)g * MG * 1024 : a.in[1]) : xg; xdst = (l == 0) ? xg : nullptr; tmp = nullptr; wpre = a.in[2] + l * 1024; }
                else if (j == 3) { wpost = a.in[3] + l * 1024; wpre = a.in[6] + l * 1024; }
                else if (j == 12) { wpost = a.in[7] + l * 1024; wpre = a.in[32] + l * 1024; scale = 1.0f; }
                else { wpost = a.in[33] + l * 1024; xn = nullptr; }
                norm_rows(xsrc, xdst, tmp, wpost, scale, wpre, xn);
            } else if (j == 1 || j == 13) {
                pg8::Gemm gm{XN, (const bf16_t*)(ws + (j == 1 ? WS_GU1 : WS_GU2)), MG, 5632, 1024, 1024, 1024}; pg8::StaticOrder S; S.init(MG, 5632, G, bid); pg8::EpiSwiGLU E{ACT, DFF}; pg8::gemm_phase(lds, gm, S, E);
            } else if (j == 2 || j == 4 || j == 9 || j == 11 || j == 14) {
                const bf16_t* A = ACT; const bf16_t* Bt = (const bf16_t*)(ws + WS_DN1); int N = 1024, K = DFF, lda = DFF, ldc = 1024, reps = 1; bf16_t* O = TMP;
                if (j == 14) Bt = (const bf16_t*)(ws + WS_DN2);
                else if (j == 4) { A = XN; Bt = (const bf16_t*)(ws + WS_INT); N = NPROJ; K = 1024; lda = 1024; O = PROJ; ldc = NPROJ; }
                else if (j == 9) { A = YS; Bt = (const bf16_t*)(ws + WS_BR); K = 256; lda = 1024; O = YB; ldc = 4096; reps = 4; }
                else if (j == 11) { A = MERGED; Bt = (const bf16_t*)(ws + WS_OUT); K = 1024; lda = 1024; }
#pragma unroll 1
                for (int nb = 0; nb < reps; ++nb) {
                    pg8::Gemm gm{A + nb * 256, Bt + (size_t)nb * 1024 * 256, MG, N, K, lda, K}; pg8::StaticOrder S; S.init(MG, N, G, bid); pg8::EpiBf16 E{O + nb * 1024, ldc}; pg8::gemm_phase(lds, gm, S, E);
                }
            } else if (j == 10) {
                pg8::Gemm gm{XN, (const bf16_t*)(ws + WS_GT), MG, 4096, 1024, 1024, 1024}; pg8::StaticOrder S; S.init(MG, 4096, G, bid); pg8::EpiMerge E{YB, MERGED}; pg8::gemm_phase(lds, gm, S, E);
            } else if (j == 5) prescan_phase(a, l);
            else if (j == 6) hyena_phase(a, l, (float2*)lds_raw);
            else if (j == 7) scan_phase(a);
            else postscan_phase(a, l);
        }
        if (pc + 1 < hi) grid.sync();
    }
}
constexpr int N_PHASES = 2 * (2 + NGRP * 16);

extern "C" void kernel_launch(void* const* d_in, const int* in_sizes, int n_in, void* d_out, int out_size, void* d_ws, size_t ws_size, hipStream_t stream) {
    static int grid = 0;
    if (grid == 0) {
        if (n_in != 36 || ws_size < WS_END) { fprintf(stderr, "kernel_launch: need 36 inputs and %zu bytes of workspace (got %d, %zu)\n", (size_t)WS_END, n_in, ws_size); grid = -1; return; }
        int dev = 0, cus = 0, per_cu = 0;
        (void)hipGetDevice(&dev); (void)hipDeviceGetAttribute(&cus, hipDeviceAttributeMultiprocessorCount, dev);
        if (hipFuncSetAttribute((const void*)hybrid_fwd, hipFuncAttributeMaxDynamicSharedMemorySize, LDS_BYTES) != hipSuccess) { fprintf(stderr, "kernel_launch: hipFuncSetAttribute failed\n"); grid = -1; return; }
        if (hipOccupancyMaxActiveBlocksPerMultiprocessor(&per_cu, (const void*)hybrid_fwd, 512, LDS_BYTES) != hipSuccess || per_cu < 1) { fprintf(stderr, "kernel_launch: occupancy query gave %d\n", per_cu); per_cu = 1; }
        (void)hipGetLastError();
        grid = cus * 1;
    }
    if (grid < 0) return;
    KArgs a{};
    for (int i = 0; i < 36; ++i) a.in[i] = (const float*)d_in[i];
    a.out = (float*)d_out; a.ws = (unsigned char*)d_ws; a.ph_lo = 0; a.ph_hi = N_PHASES;
    void* args[] = {&a};
    hipError_t e = hipLaunchCooperativeKernel((const void*)hybrid_fwd, dim3(grid), dim3(512), args, LDS_BYTES, stream);
    if (e != hipSuccess) fprintf(stderr, "cooperative launch failed: %s (grid %d)\n", hipGetErrorString(e), grid);
}
```

```cpp
#include <hip/hip_runtime.h>
#include <hip/hip_cooperative_groups.h>
#include <cstdio>
namespace cg = cooperative_groups;

#define LAS __attribute__((address_space(3)))
typedef unsigned short bf16_t;
typedef short bf16x8 __attribute__((ext_vector_type(8)));
typedef float f32x4 __attribute__((ext_vector_type(4)));
typedef unsigned u32x4 __attribute__((ext_vector_type(4)));
typedef unsigned u32x2 __attribute__((ext_vector_type(2)));

constexpr int DM = 1024, SEQ = 8192, DFF = 2816;
constexpr int GS = 2, MG = GS * SEQ, NGRP = 3;
constexpr int NPROJ = 3840, NIN = 7720, NNG = 3624;
constexpr int SCW = 1280;
constexpr int FN = 16384;
constexpr int SPP = 8200;
constexpr float EPS = 1e-6f;
constexpr int C_HY = 0, C_M2Z = 768, C_XBC = 1024, C_DT = 1536, C_GQ = 1544, C_GK = 1672, C_GV = 1800, C_GA = 2056, C_GG = 2088,
              C_HQ = 2344, C_HF = 2600, C_HI = 3112, C_HGG = 3368;
constexpr size_t WS_GU1 = 0;
constexpr size_t WS_DN1 = WS_GU1 + (size_t)5632 * 1024 * 2;
constexpr size_t WS_INT = WS_DN1 + (size_t)1024 * 2816 * 2;
constexpr size_t WS_GT  = WS_INT + (size_t)NPROJ * 1024 * 2;
constexpr size_t WS_BR  = WS_GT + (size_t)4096 * 1024 * 2;
constexpr size_t WS_OUT = WS_BR + (size_t)4 * 1024 * 256 * 2;
constexpr size_t WS_GU2 = WS_OUT + (size_t)1024 * 1024 * 2;
constexpr size_t WS_DN2 = WS_GU2 + (size_t)5632 * 1024 * 2;
constexpr size_t WS_H2  = WS_DN2 + (size_t)1024 * 2816 * 2;
constexpr size_t WS_SP  = WS_H2 + (size_t)8192 * 64 * 4;
constexpr size_t WS_XN  = WS_SP + (size_t)256 * SPP * 16;
constexpr size_t WS_PROJ = WS_XN + (size_t)MG * 1024 * 2;
constexpr size_t WS_SC  = WS_PROJ + (size_t)MG * NPROJ * 2;
constexpr size_t WS_DTA = WS_SC + (size_t)MG * SCW * 2;
constexpr size_t WS_SO  = WS_DTA + (size_t)MG * 16 * 4;
constexpr size_t WS_YS  = WS_SO + (size_t)2 * MG * 768 * 2;
constexpr size_t WS_TMP = WS_YS + (size_t)MG * 1024 * 2;
constexpr size_t WS_STH = WS_TMP + (size_t)MG * 1024 * 2;
constexpr size_t WS_STG = WS_STH + (size_t)16 * 128 * 64 * 64 * 4;
constexpr size_t WS_DC  = WS_STG + (size_t)16 * 128 * 64 * 32 * 4;
constexpr size_t WS_END = WS_DC + (size_t)3 * 16 * 128 * 64 * 4;
constexpr int LDS_BYTES = 131072 + 4096;

struct KArgs { const float* in[36]; float* out; unsigned char* ws; int ph_lo, ph_hi; };

__device__ __forceinline__ float bf_lo(unsigned w) { return __uint_as_float(w << 16); }
__device__ __forceinline__ float bf_hi(unsigned w) { return __uint_as_float(w & 0xffff0000u); }
__device__ __forceinline__ float bf2f(bf16_t b) { return __uint_as_float(((unsigned)b) << 16); }
__device__ __forceinline__ bf16_t f2bf(float f) { unsigned u = __float_as_uint(f); u += 0x7FFFu + ((u >> 16) & 1u); return (bf16_t)(u >> 16); }
__device__ __forceinline__ unsigned pk_bf16(float lo, float hi) { unsigned r; asm volatile("v_cvt_pk_bf16_f32 %0, %1, %2" : "=v"(r) : "v"(lo), "v"(hi)); return r; }
__device__ __forceinline__ float sigmoidf_(float x) { return __builtin_amdgcn_rcpf(1.0f + __expf(-x)); }
__device__ __forceinline__ float siluf_(float x) { return x * sigmoidf_(x); }
__device__ __forceinline__ float softplusf_(float x) { return fmaxf(x, 0.f) + __logf(1.0f + __expf(-fabsf(x))); }
__device__ __forceinline__ float sin_rad(float x) { return __builtin_amdgcn_sinf(x * 0.15915494309189535f); }
__device__ __forceinline__ float wave_sum(float v) {
#pragma unroll
    for (int o = 32; o >= 1; o >>= 1) v += __shfl_xor(v, o);
    return v;
}


__device__ __forceinline__ int tidx() { int t = threadIdx.x; asm volatile("" : "+v"(t)); return t; }
__device__ __forceinline__ int bidx() { int b = blockIdx.x; asm volatile("" : "+s"(b)); return b; }
__device__ __forceinline__ int gdim() { int g = gridDim.x; asm volatile("" : "+s"(g)); return g; }

namespace pg8 {
constexpr int BM = 256, BK = 64, HALF = 128, HTB = HALF * BK * 2, NXCD = 8, WGM = 8;
__device__ __forceinline__ int lds_byte(int r, int c) { const int st = (r >> 4) * 2 + (c >> 5), rr = r & 15, cc = c & 31, ob = rr * 64 + cc * 2; return st * 1024 + (ob ^ (((ob >> 9) & 1) << 5)); }
__device__ __forceinline__ void stage_rc(int b, int& R, int& C) { const int st = b / 1024, sb = b % 1024, swz = sb ^ (((sb >> 9) & 1) << 5); R = (st >> 1) * 16 + swz / 64; C = (st & 1) * 32 + (swz % 64) / 2; }
__device__ __forceinline__ int perm32(int rho) { const int n = rho >> 4, i = rho & 15; return 8 * (i >> 2) + 4 * n + (i & 3); }
struct Unit { int pm, pn; };
struct Gemm { const bf16_t* A; const bf16_t* Bt; int M, N, K, lda, ldb; };
struct StaticOrder {
    int nM, nN, nwg, G, c;
    __device__ void init(int M, int N, int G_, int c_) { nM = M / BM; nN = N / BM; nwg = nM * nN; G = G_; c = c_; }
    __device__ bool next(int i, Unit& u) const {
        const long L = (long)i * G + c; if (L >= nwg) return false;
        int wgid = (int)L; { const int q = nwg / NXCD, r = nwg % NXCD, xcd = wgid % NXCD, off = wgid / NXCD; wgid = (xcd < r ? xcd * (q + 1) : r * (q + 1) + (xcd - r) * q) + off; }
        const int nig = WGM * nN, gid = wgid / nig, fm = gid * WGM, gsz = (nM - fm) < WGM ? (nM - fm) : WGM;
        u.pm = fm + ((wgid % nig) % gsz); u.pn = (wgid % nig) / gsz; return true;
    }
};

template <class Epi>
__device__ __forceinline__ void gemm_phase(LAS unsigned char* lds, const Gemm g, const StaticOrder& S, const Epi& E) {
    const int tid = tidx(), wid = __builtin_amdgcn_readfirstlane(tid >> 6), lane = tid & 63, wr = wid >> 2, wc = wid & 3, fr = lane & 15, fq = lane >> 4;
    const int K = g.K, nt = K / BK;
    unsigned voffA[2], voffB[2];
#pragma unroll
    for (int i = 0; i < 2; ++i) { int R, C; stage_rc(tid * 16 + i * 8192, R, C); const int Rb = Epi::PERM ? ((R & ~31) + perm32(R & 31)) : R;
        voffA[i] = (unsigned)(R * g.lda + C) * 2u; voffB[i] = (unsigned)(Rb * g.ldb + C) * 2u; }
    const size_t kstep = (size_t)(BK * 2);
    const size_t hstepA = (size_t)HALF * g.lda * 2, hstepB = (size_t)HALF * g.ldb * 2;
    const size_t tstepA = 2 * hstepA, tstepB = 2 * hstepB;
    const unsigned ldsw = (unsigned)wid * 1024u;
    const int aoff = lds_byte(wr * 64 + fr, fq * 8), boff = lds_byte(wc * 32 + fr, fq * 8);
#define PG8_SA(b, h) (((b) * 2 + (h)) * HTB)
#define PG8_SB(b, h) ((4 + (b) * 2 + (h)) * HTB)
#define PG8_STAGE(bufoff, gbase, voff) do { _Pragma("unroll") for (int _i = 0; _i < 2; ++_i) \
        __builtin_amdgcn_global_load_lds((const unsigned*)((const char*)(gbase) + (voff)[_i]), (LAS unsigned*)(lds + (bufoff) + ldsw + _i * 8192), 16, 0, 0); } while (0)
#define PG8_LDA(dst, b, h) do { _Pragma("unroll") for (int m = 0; m < 4; ++m) _Pragma("unroll") for (int k = 0; k < 2; ++k) dst[m][k] = *(const LAS bf16x8*)(lds + PG8_SA(b, h) + aoff + m * 2048 + k * 1024); } while (0)
#define PG8_LDB(dst, b, h) do { _Pragma("unroll") for (int n = 0; n < 2; ++n) _Pragma("unroll") for (int k = 0; k < 2; ++k) dst[n][k] = *(const LAS bf16x8*)(lds + PG8_SB(b, h) + boff + n * 2048 + k * 1024); } while (0)
#define PG8_MMA(ai, bj, At, Bt) do { __builtin_amdgcn_s_setprio(1); _Pragma("unroll") for (int m = 0; m < 4; ++m) _Pragma("unroll") for (int n = 0; n < 2; ++n) _Pragma("unroll") for (int k = 0; k < 2; ++k) \
        acc[ai][bj][m][n] = __builtin_amdgcn_mfma_f32_16x16x32_bf16(Bt[n][k], At[m][k], acc[ai][bj][m][n], 0, 0, 0); __builtin_amdgcn_s_setprio(0); } while (0)
#define PG8_WAIT_V(n) asm volatile("s_waitcnt vmcnt(" #n ")" ::: "memory")
#define PG8_WAIT_L(n) asm volatile("s_waitcnt lgkmcnt(" #n ")" ::: "memory")
#define PG8_BAR __builtin_amdgcn_s_barrier()
#define PG8_SCHED __builtin_amdgcn_sched_barrier(0)
    Unit cur, nxt; int ui = 0;
    if (!S.next(0, cur)) return;
    f32x4 acc[2][2][4][2];
#pragma unroll
    for (int a = 0; a < 2; ++a)
#pragma unroll
        for (int b = 0; b < 2; ++b)
#pragma unroll
            for (int m = 0; m < 4; ++m)
#pragma unroll
                for (int n = 0; n < 2; ++n) acc[a][b][m][n] = (f32x4){0.f, 0.f, 0.f, 0.f};
    bf16x8 At[4][2], B0[2][2], B1[2][2];
    const char* cA = (const char*)g.A + (size_t)cur.pm * tstepA; const char* cB = (const char*)g.Bt + (size_t)cur.pn * tstepB;
    PG8_STAGE(PG8_SB(0, 0), cB, voffB); PG8_STAGE(PG8_SA(0, 0), cA, voffA); PG8_STAGE(PG8_SB(0, 1), cB + hstepB, voffB); PG8_STAGE(PG8_SA(0, 1), cA + hstepA, voffA);
    if (wr == 1) PG8_BAR;
    PG8_WAIT_V(4); PG8_BAR;
    PG8_STAGE(PG8_SB(1, 0), cB + kstep, voffB); PG8_STAGE(PG8_SA(1, 0), cA + kstep, voffA); PG8_STAGE(PG8_SB(1, 1), cB + hstepB + kstep, voffB);
    PG8_WAIT_V(6); PG8_BAR;
    for (;;) {
        const bool has_next = S.next(ui + 1, nxt);
        const char* nA = has_next ? (const char*)g.A + (size_t)nxt.pm * tstepA : cA; const char* nB = has_next ? (const char*)g.Bt + (size_t)nxt.pn * tstepB : cB;
        for (int t = 0; t < nt; t += 2) {
            const bool last = (t == nt - 2);
            const char* a1 = cA + (size_t)(t + 1) * kstep;
            const char* a2 = last ? nA : cA + (size_t)(t + 2) * kstep; const char* b2 = last ? nB : cB + (size_t)(t + 2) * kstep;
            const char* a3 = a2 + kstep; const char* b3 = b2 + kstep;
            PG8_LDB(B0, 0, 0); PG8_SCHED; PG8_LDA(At, 0, 0); PG8_STAGE(PG8_SA(1, 1), a1 + hstepA, voffA);
            PG8_WAIT_L(8); PG8_BAR; PG8_WAIT_L(0); PG8_MMA(0, 0, At, B0); PG8_BAR; PG8_SCHED;
            PG8_LDB(B1, 0, 1); PG8_STAGE(PG8_SB(0, 0), b2, voffB);
            PG8_BAR; PG8_WAIT_L(0); PG8_MMA(0, 1, At, B1); PG8_BAR;
            PG8_LDA(At, 0, 1); PG8_STAGE(PG8_SA(0, 0), a2, voffA);
            PG8_BAR; PG8_WAIT_L(0); PG8_MMA(1, 0, At, B0); PG8_BAR; PG8_SCHED;
            PG8_STAGE(PG8_SB(0, 1), b2 + hstepB, voffB);
            PG8_WAIT_V(6); PG8_BAR; PG8_MMA(1, 1, At, B1); PG8_BAR;
            PG8_LDB(B0, 1, 0); PG8_SCHED; PG8_LDA(At, 1, 0); PG8_STAGE(PG8_SA(0, 1), a2 + hstepA, voffA);
            PG8_WAIT_L(8); PG8_BAR; PG8_WAIT_L(0); PG8_MMA(0, 0, At, B0); PG8_BAR; PG8_SCHED;
            PG8_LDB(B1, 1, 1); PG8_STAGE(PG8_SB(1, 0), b3, voffB);
            PG8_BAR; PG8_WAIT_L(0); PG8_MMA(0, 1, At, B1); PG8_BAR;
            PG8_LDA(At, 1, 1); PG8_STAGE(PG8_SA(1, 0), a3, voffA);
            PG8_BAR; PG8_WAIT_L(0); PG8_MMA(1, 0, At, B0); PG8_BAR; PG8_SCHED;
            PG8_STAGE(PG8_SB(1, 1), b3 + hstepB, voffB);
            PG8_WAIT_V(6); PG8_BAR; PG8_MMA(1, 1, At, B1); PG8_BAR;
        }
        E(acc, cur, wr, wc, fr, fq);
        if (!has_next) break;
#pragma unroll
        for (int a = 0; a < 2; ++a)
#pragma unroll
            for (int b = 0; b < 2; ++b)
#pragma unroll
                for (int m = 0; m < 4; ++m)
#pragma unroll
                    for (int n = 0; n < 2; ++n) acc[a][b][m][n] = (f32x4){0.f, 0.f, 0.f, 0.f};
        cur = nxt; cA = nA; cB = nB; ++ui;
    }
    PG8_WAIT_V(0);
    if (wr == 0) PG8_BAR;
    PG8_BAR;
#undef PG8_SA
#undef PG8_SB
#undef PG8_STAGE
#undef PG8_LDA
#undef PG8_LDB
#undef PG8_MMA
#undef PG8_WAIT_V
#undef PG8_WAIT_L
#undef PG8_BAR
#undef PG8_SCHED
}

struct EpiBf16 {
    static constexpr bool PERM = true;
    bf16_t* O; int ldc;
    __device__ __forceinline__ void operator()(const f32x4 (&acc)[2][2][4][2], const Unit& u, int wr, int wc, int fr, int fq) const {
        const int row0 = u.pm * BM + wr * 64 + fr, col0 = u.pn * BM + wc * 32 + 8 * fq;
#pragma unroll
        for (int ai = 0; ai < 2; ++ai)
#pragma unroll
            for (int m = 0; m < 4; ++m) { bf16_t* rowp = O + (size_t)(row0 + ai * HALF + m * 16) * ldc + col0;
#pragma unroll
                for (int bj = 0; bj < 2; ++bj) { const f32x4 v0 = acc[ai][bj][m][0], v1 = acc[ai][bj][m][1];
                    u32x4 w; w.x = pk_bf16(v0[0], v0[1]); w.y = pk_bf16(v0[2], v0[3]); w.z = pk_bf16(v1[0], v1[1]); w.w = pk_bf16(v1[2], v1[3]);
                    *(u32x4*)(rowp + bj * HALF) = w; } }
    }
};
struct EpiSwiGLU {
    static constexpr bool PERM = true;
    bf16_t* O; int ldc;
    __device__ __forceinline__ void operator()(const f32x4 (&acc)[2][2][4][2], const Unit& u, int wr, int wc, int fr, int fq) const {
        const int row0 = u.pm * BM + wr * 64 + fr, col0 = u.pn * HALF + wc * 32 + 8 * fq;
#pragma unroll
        for (int ai = 0; ai < 2; ++ai)
#pragma unroll
            for (int m = 0; m < 4; ++m) { bf16_t* rowp = O + (size_t)(row0 + ai * HALF + m * 16) * ldc + col0;
                const f32x4 g0 = acc[ai][0][m][0], g1 = acc[ai][0][m][1], u0 = acc[ai][1][m][0], u1 = acc[ai][1][m][1];
                float r[8];
#pragma unroll
                for (int j = 0; j < 4; ++j) { r[j] = siluf_(g0[j]) * u0[j]; r[4 + j] = siluf_(g1[j]) * u1[j]; }
                u32x4 w; w.x = pk_bf16(r[0], r[1]); w.y = pk_bf16(r[2], r[3]); w.z = pk_bf16(r[4], r[5]); w.w = pk_bf16(r[6], r[7]);
                *(u32x4*)rowp = w; }
    }
};
struct EpiMerge {
    static constexpr bool PERM = false;
    const bf16_t* Y; bf16_t* O;
    __device__ __forceinline__ void operator()(const f32x4 (&acc)[2][2][4][2], const Unit& u, int wr, int wc, int fr, int fq) const {
        const int row0 = u.pm * BM + wr * 64 + fr, c0 = u.pn * 64 + wc * 16 + 4 * fq;
#pragma unroll
        for (int ai = 0; ai < 2; ++ai)
#pragma unroll
            for (int m = 0; m < 4; ++m) { const size_t row = (size_t)(row0 + ai * HALF + m * 16);
                float s[4] = {0.f, 0.f, 0.f, 0.f};
#pragma unroll
                for (int bj = 0; bj < 2; ++bj)
#pragma unroll
                    for (int n = 0; n < 2; ++n) { const u32x2 y = *(const u32x2*)(Y + row * 4096 + (2 * bj + n) * 1024 + c0); const f32x4 a = acc[ai][bj][m][n];
                        s[0] += sigmoidf_(a[0]) * bf_lo(y.x); s[1] += sigmoidf_(a[1]) * bf_hi(y.x); s[2] += sigmoidf_(a[2]) * bf_lo(y.y); s[3] += sigmoidf_(a[3]) * bf_hi(y.y); }
                u32x2 w; w.x = pk_bf16(s[0], s[1]); w.y = pk_bf16(s[2], s[3]);
                *(u32x2*)(O + row * 1024 + c0) = w; }
    }
};
}

__device__ __forceinline__ int srccol(int kind, int n) {
    if (kind == 0) { const int pn = n >> 8, w = n & 255; return w < 128 ? pn * 128 + w : DFF + pn * 128 + (w - 128); }
    if (kind == 1) return n;
    if (kind == 2) return n < NNG ? n : -1;
    const int pn = n >> 8, T = n & 255, bj = T >> 7, wc = (T >> 5) & 3, nn = (T >> 4) & 1, fq = (T >> 2) & 3, j = T & 3;
    return NNG + (2 * bj + nn) * 1024 + 64 * pn + 16 * wc + 4 * fq + j;
}
__device__ void prep_weights(const KArgs& a, int l, float* tile) {
    unsigned char* ws = a.ws; const int tid = tidx();
    for (int tix = bidx(); tix < 6720; tix += gdim()) {
        int tl = tix, kind, K, ld, NT; const float* src; bf16_t* dst;
        if (tl < 1408) { kind = 0; src = a.in[4] + (size_t)l * 1024 * 5632; dst = (bf16_t*)(ws + WS_GU1); K = 1024; ld = 5632; NT = 88; }
        else if ((tl -= 1408) < 704) { kind = 1; src = a.in[5] + (size_t)l * DFF * 1024; dst = (bf16_t*)(ws + WS_DN1); K = DFF; ld = 1024; NT = 16; }
        else if ((tl -= 704) < 960) { kind = 2; src = a.in[8] + (size_t)l * 1024 * NIN; dst = (bf16_t*)(ws + WS_INT); K = 1024; ld = NIN; NT = 60; }
        else if ((tl -= 960) < 1024) { kind = 3; src = a.in[8] + (size_t)l * 1024 * NIN; dst = (bf16_t*)(ws + WS_GT); K = 1024; ld = NIN; NT = 64; }
        else if ((tl -= 1024) < 256) { kind = 1; const int nb = tl >> 6; tl &= 63; src = a.in[30] + (size_t)(l * 4 + nb) * 256 * 1024; dst = (bf16_t*)(ws + WS_BR) + (size_t)nb * 1024 * 256; K = 256; ld = 1024; NT = 16; }
        else if ((tl -= 256) < 256) { kind = 1; src = a.in[31] + (size_t)l * 1024 * 1024; dst = (bf16_t*)(ws + WS_OUT); K = 1024; ld = 1024; NT = 16; }
        else if ((tl -= 256) < 1408) { kind = 0; src = a.in[34] + (size_t)l * 1024 * 5632; dst = (bf16_t*)(ws + WS_GU2); K = 1024; ld = 5632; NT = 88; }
        else { tl -= 1408; kind = 1; src = a.in[35] + (size_t)l * DFF * 1024; dst = (bf16_t*)(ws + WS_DN2); K = DFF; ld = 1024; NT = 16; }
        const int tn = tl % NT, tk = tl / NT, n0 = tn * 64, k0 = tk * 64;
        const int cidx = tid & 63, r = tid >> 6;
        const int sc = srccol(kind, n0 + cidx);
#pragma unroll
        for (int rr = 0; rr < 8; ++rr) { const int kl = rr * 8 + r; tile[kl * 65 + cidx] = sc >= 0 ? src[(size_t)(k0 + kl) * ld + sc] : 0.f; }
        __syncthreads();
#pragma unroll
        for (int rr = 0; rr < 8; ++rr) { const int nl = rr * 8 + r; dst[(size_t)(n0 + nl) * K + k0 + cidx] = f2bf(tile[cidx * 65 + nl]); }
        __syncthreads();
    }
}
__device__ void filter_hidden(const KArgs& a, int l, float* h1s) {
    const int tid = tidx(), p = tid >> 6, u = tid & 63;
    const float* w1 = a.in[11] + (size_t)l * 33 * 64; const float* b1 = a.in[12] + l * 64; const float* w2 = a.in[13] + (size_t)l * 64 * 64; const float* b2 = a.in[14] + l * 64;
    const float* fr = a.in[15] + (size_t)l * 128;
    float* H2 = (float*)(a.ws + WS_H2);
    for (int pb = bidx(); pb < 1024; pb += gdim()) {
        const int t = pb * 8 + p; const float tp = (float)t * (1.0f / 8191.0f);
        float acc = b1[u] + tp * w1[u];
#pragma unroll
        for (int j = 0; j < 16; ++j) { const float band = 1e-4f + (float)j * ((15.0f - 1e-4f) / 15.0f);
            float rev = (band * (float)t) * (1.0f / 8192.0f); rev -= floorf(rev);
            const float c = __builtin_amdgcn_cosf(rev), s = __builtin_amdgcn_sinf(rev);
            acc += c * w1[(1 + j) * 64 + u] - s * w1[(17 + j) * 64 + u]; }
        h1s[p * 64 + u] = sin_rad(fr[u] * acc);
        __syncthreads();
        float acc2 = b2[u];
#pragma unroll 8
        for (int k = 0; k < 64; ++k) acc2 += h1s[p * 64 + k] * w2[k * 64 + u];
        H2[(size_t)t * 64 + u] = sin_rad(fr[64 + u] * acc2);
        __syncthreads();
    }
}

__device__ __forceinline__ void fft_fwd(float2* X, int tid) {
#pragma unroll 1
    for (int h = FN / 2; h >= 1; h >>= 1) {
        const float inv2h = 0.5f / (float)h;
#pragma unroll 2
        for (int b = tid; b < FN / 2; b += 512) {
            const int j = b & (h - 1), i = ((b - j) << 1) + j;
            const float2 x0 = X[i], x1 = X[i + h];
            const float f = -(float)j * inv2h;
            const float cw = __builtin_amdgcn_cosf(f), sw = __builtin_amdgcn_sinf(f);
            const float dx = x0.x - x1.x, dy = x0.y - x1.y;
            X[i] = make_float2(x0.x + x1.x, x0.y + x1.y);
            X[i + h] = make_float2(dx * cw - dy * sw, dx * sw + dy * cw);
        }
        __syncthreads();
    }
}
__device__ __forceinline__ void fft_inv(float2* X, int tid) {
#pragma unroll 1
    for (int h = 1; h <= FN / 2; h <<= 1) {
        const float inv2h = 0.5f / (float)h;
#pragma unroll 2
        for (int b = tid; b < FN / 2; b += 512) {
            const int j = b & (h - 1), i = ((b - j) << 1) + j;
            const float2 x0 = X[i], x1 = X[i + h];
            const float f = (float)j * inv2h;
            const float cw = __builtin_amdgcn_cosf(f), sw = __builtin_amdgcn_sinf(f);
            const float cx = x1.x * cw - x1.y * sw, cy = x1.x * sw + x1.y * cw;
            X[i] = make_float2(x0.x + cx, x0.y + cy);
            X[i + h] = make_float2(x0.x - cx, x0.y - cy);
        }
        __syncthreads();
    }
}
__device__ __forceinline__ int brev14(int k) { return (int)(__brev((unsigned)k) >> 18); }

__device__ void filter_spectra(const KArgs& a, int l, float2* X, float* w3s) {
    const int tid = tidx();
    const float* H2 = (const float*)(a.ws + WS_H2);
    float4* SP = (float4*)(a.ws + WS_SP);
    const float* w3 = a.in[16] + (size_t)l * 64 * 1024; const float* dec = a.in[17] + (size_t)l * 1024;
    for (int item = bidx(); item < 256; item += gdim()) {
        const int o = item >> 7, cp = item & 127, c = 2 * cp;
        if (tid < 256) { const int k = tid >> 2, q = tid & 3; w3s[k * 4 + q] = w3[(size_t)k * 1024 + o * 512 + (q >> 1) * 256 + c + (q & 1)]; }
        const float dc0 = fabsf(dec[o * 512 + c]), dc1 = fabsf(dec[o * 512 + c + 1]), dc2 = fabsf(dec[o * 512 + 256 + c]), dc3 = fabsf(dec[o * 512 + 256 + c + 1]);
        __syncthreads();
#pragma unroll 1
        for (int i = 0; i < 16; ++i) {
            const int t = tid + 512 * i;
            const float4* hrow = (const float4*)(H2 + (size_t)t * 64);
            float d0 = 0.f, d1 = 0.f, d2 = 0.f, d3 = 0.f;
#pragma unroll 2
            for (int k4 = 0; k4 < 16; ++k4) { const float4 hv = hrow[k4]; const float hh[4] = {hv.x, hv.y, hv.z, hv.w};
#pragma unroll
                for (int kk = 0; kk < 4; ++kk) { const float4 w = *(const float4*)(w3s + (k4 * 4 + kk) * 4); d0 += hh[kk] * w.x; d1 += hh[kk] * w.y; d2 += hh[kk] * w.z; d3 += hh[kk] * w.w; } }
            const float tp = (float)t * (1.0f / 8191.0f);
            X[t] = make_float2(d0 * __expf(-tp * dc0), d1 * __expf(-tp * dc1));
            if (t >= 1) X[FN - t] = make_float2(d2 * __expf(-tp * dc2), d3 * __expf(-tp * dc3)); else X[FN / 2] = make_float2(0.f, 0.f);
        }
        __syncthreads();
        fft_fwd(X, tid);
        const float sc = 1.0f / (float)FN;
#pragma unroll 2
        for (int j = 0; j < 16; ++j) {
            const int s = tid + 512 * j, p = 2 * s, k = brev14(p), p2 = brev14((FN - k) & (FN - 1));
            const float2 G1 = X[p], G2 = X[p2];
            SP[(size_t)item * SPP + s] = make_float4(0.5f * sc * (G1.x + G2.x), 0.5f * sc * (G1.y - G2.y), 0.5f * sc * (G1.y + G2.y), -0.5f * sc * (G1.x - G2.x));
        }
        if (tid == 0) { const float2 G1 = X[1]; SP[(size_t)item * SPP + 8192] = make_float4(sc * G1.x, 0.f, sc * G1.y, 0.f); }
        __syncthreads();
    }
}
__device__ __forceinline__ void spec_mul(float2* X, const float4* sp, int tid) {
#pragma unroll 2
    for (int j = 0; j < 16; ++j) {
        const int s = tid + 512 * j, p = 2 * s, k = brev14(p), p2 = brev14((FN - k) & (FN - 1));
        const float4 g = sp[s];
        const float2 Z1 = X[p], Z2 = X[p2];
        const float ax = 0.5f * (Z1.x + Z2.x), ay = 0.5f * (Z1.y - Z2.y), bx = 0.5f * (Z1.y + Z2.y), by = -0.5f * (Z1.x - Z2.x);
        const float agx = ax * g.x - ay * g.y, agy = ax * g.y + ay * g.x, bgx = bx * g.z - by * g.w, bgy = bx * g.w + by * g.z;
        X[p2] = make_float2(agx + bgy, -agy + bgx);
        X[p] = make_float2(agx - bgy, agy + bgx);
    }
    if (tid == 0) { const float4 g = sp[8192]; const float2 Z1 = X[1]; X[1] = make_float2(Z1.x * g.x, Z1.y * g.z); }
    __syncthreads();
}
__device__ __forceinline__ float2 conv_pair(const bf16_t* pr, int t, int col, const float* cw, const float* cb) {
    asm volatile("" : "+v"(t));
    const unsigned* p0 = (const unsigned*)(pr + (size_t)t * NPROJ + col);
    const unsigned m0 = *p0;
    unsigned mm = *(t >= 1 ? p0 - NPROJ / 2 : p0);
    unsigned mp = *(t + 1 < SEQ ? p0 + NPROJ / 2 : p0);
    mm = t >= 1 ? mm : 0u; mp = t + 1 < SEQ ? mp : 0u;
    float2 r;
    r.x = cb[col] + cw[col] * bf_lo(mm) + cw[768 + col] * bf_lo(m0) + cw[1536 + col] * bf_lo(mp);
    r.y = cb[col + 1] + cw[col + 1] * bf_hi(mm) + cw[768 + col + 1] * bf_hi(m0) + cw[1536 + col + 1] * bf_hi(mp);
    return r;
}
__device__ void hyena_phase(const KArgs& a, int l, float2* X) {
    const int tid = tidx();
    const bf16_t* proj = (const bf16_t*)(a.ws + WS_PROJ); bf16_t* ys = (bf16_t*)(a.ws + WS_YS);
    const float4* SP = (const float4*)(a.ws + WS_SP);
    const float* cw = a.in[9] + (size_t)l * 3 * 768; const float* cb = a.in[10] + (size_t)l * 768; const float* hb = a.in[18] + (size_t)l * 512;
    for (int item = bidx(); item < GS * 128; item += gdim()) {
        const int s = item >> 7, cp = item & 127, c = 2 * cp;
        const bf16_t* pr = proj + (size_t)s * SEQ * NPROJ;
        float2 vreg[16], zreg[16];
#pragma unroll
        for (int i = 0; i < 16; ++i) { const int t = tid + 512 * i; vreg[i] = conv_pair(pr, t, c, cw, cb); X[t] = vreg[i]; X[t + SEQ] = make_float2(0.f, 0.f); if ((i & 3) == 3) __builtin_amdgcn_sched_barrier(0); }
        __syncthreads();
        fft_fwd(X, tid); spec_mul(X, SP + (size_t)cp * SPP, tid); fft_inv(X, tid);
        const float b00 = hb[c], b01 = hb[c + 1], b10 = hb[256 + c], b11 = hb[256 + c + 1];
#pragma unroll
        for (int i = 0; i < 16; ++i) { const int t = tid + 512 * i; const float2 y = X[t]; const float2 x1 = conv_pair(pr, t, 256 + c, cw, cb);
            zreg[i] = make_float2(x1.x * (y.x + b00 * vreg[i].x), x1.y * (y.y + b01 * vreg[i].y)); if ((i & 3) == 3) __builtin_amdgcn_sched_barrier(0); }
        __syncthreads();
#pragma unroll
        for (int i = 0; i < 16; ++i) { const int t = tid + 512 * i; X[t] = zreg[i]; X[t + SEQ] = make_float2(0.f, 0.f); }
        __syncthreads();
        fft_fwd(X, tid); spec_mul(X, SP + (size_t)(128 + cp) * SPP, tid); fft_inv(X, tid);
#pragma unroll
        for (int i = 0; i < 16; ++i) { const int t = tid + 512 * i; const float2 y = X[t]; const float2 x2 = conv_pair(pr, t, 512 + c, cw, cb);
            *(unsigned*)(ys + (size_t)(s * SEQ + t) * 1024 + c) = pk_bf16(x2.x * (y.x + b10 * zreg[i].x), x2.y * (y.y + b11 * zreg[i].y)); if ((i & 3) == 3) __builtin_amdgcn_sched_barrier(0); }
        __syncthreads();
    }
}

__device__ void norm_rows(const float* xsrc, float* xdst, const bf16_t* tmp, const float* w_post, float scale, const float* w_pre, bf16_t* xn) {
    const int wave = tidx() >> 6, lane = tidx() & 63;
    for (int r = bidx() * 8 + wave; r < MG; r += gdim() * 8) {
        float x[16];
#pragma unroll
        for (int hh = 0; hh < 2; ++hh) { const float4* p = (const float4*)(xsrc + (size_t)r * 1024 + hh * 512 + lane * 8); const float4 v0 = p[0], v1 = p[1];
            x[hh * 8 + 0] = v0.x; x[hh * 8 + 1] = v0.y; x[hh * 8 + 2] = v0.z; x[hh * 8 + 3] = v0.w; x[hh * 8 + 4] = v1.x; x[hh * 8 + 5] = v1.y; x[hh * 8 + 6] = v1.z; x[hh * 8 + 7] = v1.w; }
        if (tmp) {
            float tv[16]; float ss = 0.f;
#pragma unroll
            for (int hh = 0; hh < 2; ++hh) { const u32x4 w = *(const u32x4*)(tmp + (size_t)r * 1024 + hh * 512 + lane * 8);
                tv[hh * 8 + 0] = bf_lo(w.x); tv[hh * 8 + 1] = bf_hi(w.x); tv[hh * 8 + 2] = bf_lo(w.y); tv[hh * 8 + 3] = bf_hi(w.y); tv[hh * 8 + 4] = bf_lo(w.z); tv[hh * 8 + 5] = bf_hi(w.z); tv[hh * 8 + 6] = bf_lo(w.w); tv[hh * 8 + 7] = bf_hi(w.w); }
#pragma unroll
            for (int i = 0; i < 16; ++i) ss += tv[i] * tv[i];
            ss = wave_sum(ss);
            const float rs = scale * rsqrtf(ss * (1.0f / 1024.0f) + EPS);
#pragma unroll
            for (int hh = 0; hh < 2; ++hh) { const float4* wp = (const float4*)(w_post + hh * 512 + lane * 8); const float4 w0 = wp[0], w1 = wp[1];
                const float ww[8] = {w0.x, w0.y, w0.z, w0.w, w1.x, w1.y, w1.z, w1.w};
#pragma unroll
                for (int i = 0; i < 8; ++i) x[hh * 8 + i] += tv[hh * 8 + i] * rs * ww[i]; }
        }
        if (xdst) {
#pragma unroll
            for (int hh = 0; hh < 2; ++hh) { float4* p = (float4*)(xdst + (size_t)r * 1024 + hh * 512 + lane * 8);
                p[0] = make_float4(x[hh * 8 + 0], x[hh * 8 + 1], x[hh * 8 + 2], x[hh * 8 + 3]); p[1] = make_float4(x[hh * 8 + 4], x[hh * 8 + 5], x[hh * 8 + 6], x[hh * 8 + 7]); }
        }
        if (xn) {
            float ss = 0.f;
#pragma unroll
            for (int i = 0; i < 16; ++i) ss += x[i] * x[i];
            ss = wave_sum(ss);
            const float rs = rsqrtf(ss * (1.0f / 1024.0f) + EPS);
#pragma unroll
            for (int hh = 0; hh < 2; ++hh) { const float4* wp = (const float4*)(w_pre + hh * 512 + lane * 8); const float4 w0 = wp[0], w1 = wp[1];
                const float ww[8] = {w0.x, w0.y, w0.z, w0.w, w1.x, w1.y, w1.z, w1.w};
                u32x4 o; o.x = pk_bf16(x[hh * 8 + 0] * rs * ww[0], x[hh * 8 + 1] * rs * ww[1]); o.y = pk_bf16(x[hh * 8 + 2] * rs * ww[2], x[hh * 8 + 3] * rs * ww[3]);
                o.z = pk_bf16(x[hh * 8 + 4] * rs * ww[4], x[hh * 8 + 5] * rs * ww[5]); o.w = pk_bf16(x[hh * 8 + 6] * rs * ww[6], x[hh * 8 + 7] * rs * ww[7]);
                *(u32x4*)(xn + (size_t)r * 1024 + hh * 512 + lane * 8) = o; }
        }
    }
}

__device__ __forceinline__ void unpack8(const u32x4 w, float (&f)[8]) { f[0] = bf_lo(w.x); f[1] = bf_hi(w.x); f[2] = bf_lo(w.y); f[3] = bf_hi(w.y); f[4] = bf_lo(w.z); f[5] = bf_hi(w.z); f[6] = bf_lo(w.w); f[7] = bf_hi(w.w); }
__device__ __forceinline__ u32x4 pack8(const float (&f)[8]) { u32x4 w; w.x = pk_bf16(f[0], f[1]); w.y = pk_bf16(f[2], f[3]); w.z = pk_bf16(f[4], f[5]); w.w = pk_bf16(f[6], f[7]); return w; }
__device__ void prescan_phase(const KArgs& a, int l) {
    const bf16_t* proj = (const bf16_t*)(a.ws + WS_PROJ); bf16_t* sc = (bf16_t*)(a.ws + WS_SC); float* dta = (float*)(a.ws + WS_DTA);
    const float* mcw = a.in[19] + (size_t)l * 3 * 512; const float* mcb = a.in[20] + (size_t)l * 512;
    const float* dtb = a.in[21] + l * 8; const float* alog = a.in[22] + l * 8;
    const float* wg2 = a.in[25] + (size_t)l * 2 * 16 * 128; const float* bg = a.in[26] + (size_t)l * 256;
    const float* lbp = a.in[28];
    const int total = MG * 161;
    for (int idx = bidx() * 512 + tidx(); idx < total; idx += gdim() * 512) {
        const int tok = idx / 161, ch = idx - tok * 161, t = tok & (SEQ - 1);
        const bf16_t* row = proj + (size_t)tok * NPROJ;
        if (ch < 64) {
            const int c0 = ch * 8; float x0[8], xm[8], xp[8], o[8];
            unpack8(*(const u32x4*)(row + C_XBC + c0), x0);
            if (t >= 1) unpack8(*(const u32x4*)(row - NPROJ + C_XBC + c0), xm); else { for (int i = 0; i < 8; ++i) xm[i] = 0.f; }
            if (t + 1 < SEQ) unpack8(*(const u32x4*)(row + NPROJ + C_XBC + c0), xp); else { for (int i = 0; i < 8; ++i) xp[i] = 0.f; }
#pragma unroll
            for (int i = 0; i < 8; ++i) o[i] = siluf_(mcb[c0 + i] + mcw[c0 + i] * xm[i] + mcw[512 + c0 + i] * x0[i] + mcw[1024 + c0 + i] * xp[i]);
            *(u32x4*)(sc + (size_t)tok * SCW + c0) = pack8(o);
        } else if (ch == 64) {
            float z[8]; unpack8(*(const u32x4*)(row + C_DT), z);
            float dt[8], av[8];
#pragma unroll
            for (int i = 0; i < 8; ++i) { dt[i] = softplusf_(z[i] + dtb[i]); av[i] = __expf(-dt[i] * __expf(alog[i])); }
            float4* d = (float4*)(dta + (size_t)tok * 16);
            d[0] = make_float4(dt[0], dt[1], dt[2], dt[3]); d[1] = make_float4(dt[4], dt[5], dt[6], dt[7]);
            d[2] = make_float4(av[0], av[1], av[2], av[3]); d[3] = make_float4(av[4], av[5], av[6], av[7]);
        } else if (ch < 97) {
            const int gc = ch - 65, dir = gc >> 4, k0 = (gc & 15) * 8;
            float ga[16];
            { float t8[8]; unpack8(*(const u32x4*)(row + C_GA + dir * 16), t8); for (int i = 0; i < 8; ++i) ga[i] = t8[i];
              unpack8(*(const u32x4*)(row + C_GA + dir * 16 + 8), t8); for (int i = 0; i < 8; ++i) ga[8 + i] = t8[i]; }
            float o[8];
#pragma unroll
            for (int i = 0; i < 8; ++i) o[i] = bg[dir * 128 + k0 + i];
#pragma unroll
            for (int r = 0; r < 16; ++r) { const float4* wp = (const float4*)(wg2 + (size_t)(dir * 16 + r) * 128 + k0); const float4 w0 = wp[0], w1 = wp[1];
                o[0] += ga[r] * w0.x; o[1] += ga[r] * w0.y; o[2] += ga[r] * w0.z; o[3] += ga[r] * w0.w; o[4] += ga[r] * w1.x; o[5] += ga[r] * w1.y; o[6] += ga[r] * w1.z; o[7] += ga[r] * w1.w; }
#pragma unroll
            for (int i = 0; i < 8; ++i) { const float ls = -softplusf_(-o[i]); o[i] = 1.0f - __expf(ls * (1.0f / 16.0f)); }
            *(u32x4*)(sc + (size_t)tok * SCW + 512 + dir * 128 + k0) = pack8(o);
        } else {
            const int hc = ch - 97, dir = hc >> 5, i0 = (hc & 31) * 8;
            float z[8], o[8]; unpack8(*(const u32x4*)(row + C_HF + hc * 8), z);
#pragma unroll
            for (int i = 0; i < 8; ++i) { float lb = 0.f;
                if (l > 0) { const float p0 = lbp[dir * 256 + i0 + i], p1 = lbp[512 + dir * 256 + i0 + i]; lb = sigmoidf_(p1 - p0); }
                o[i] = (1.0f - lb) * __builtin_amdgcn_rcpf(1.0f + __expf(z[i])); }
            *(u32x4*)(sc + (size_t)tok * SCW + 768 + hc * 8) = pack8(o);
        }
    }
}

template <int MODE>
__device__ __forceinline__ void scan_chain(const bf16_t* qp, const bf16_t* kp, const bf16_t* vp, const bf16_t* ap, const float* dp,
                                           bf16_t* op, int pq, int pk, int pv, int pa, int dir, int lane) {
    constexpr int DPL = MODE == 0 ? 2 : 4;
    constexpr int U = 8;
    float S[DPL];
#pragma unroll
    for (int i = 0; i < DPL; ++i) S[i] = 0.f;
    unsigned Q0[2][U], Q1[2][U], K0[2][U], K1[2][U], A0[2][U]; unsigned short V[2][U]; float DT[2][U], AS[2][U];
#define SC_LOAD(bi, base) do { _Pragma("unroll") for (int u = 0; u < U; ++u) { const int st = (base) + u; const size_t tt = (size_t)(dir ? (SEQ - 1 - st) : st); \
        if (DPL == 4) { const u32x2 q = *(const u32x2*)(qp + tt * pq); Q0[bi][u] = q.x; Q1[bi][u] = q.y; const u32x2 k = *(const u32x2*)(kp + tt * pk); K0[bi][u] = k.x; K1[bi][u] = k.y; } \
        else { Q0[bi][u] = *(const unsigned*)(qp + tt * pq); K0[bi][u] = *(const unsigned*)(kp + tt * pk); A0[bi][u] = *(const unsigned*)(ap + tt * pa); } \
        V[bi][u] = vp[tt * pv]; \
        if (MODE == 2) { DT[bi][u] = dp[tt * 16]; AS[bi][u] = dp[tt * 16 + 8]; } } } while (0)
#define SC_COMP(bi, base) do { _Pragma("unroll") for (int u = 0; u < U; ++u) { const int st = (base) + u; const size_t tt = (size_t)(dir ? (SEQ - 1 - st) : st); \
        float v = bf2f(V[bi][u]); float o; \
        if (MODE == 0) { const float q0 = bf_lo(Q0[bi][u]), q1 = bf_hi(Q0[bi][u]), k0 = bf_lo(K0[bi][u]), k1 = bf_hi(K0[bi][u]), m0 = bf_lo(A0[bi][u]), m1 = bf_hi(A0[bi][u]); \
            S[0] = (S[0] - m0 * S[0]) + k0 * v; S[1] = (S[1] - m1 * S[1]) + k1 * v; o = S[0] * q0 + S[1] * q1; } \
        else { const float q0 = bf_lo(Q0[bi][u]), q1 = bf_hi(Q0[bi][u]), q2 = bf_lo(Q1[bi][u]), q3 = bf_hi(Q1[bi][u]); \
            const float k0 = bf_lo(K0[bi][u]), k1 = bf_hi(K0[bi][u]), k2 = bf_lo(K1[bi][u]), k3 = bf_hi(K1[bi][u]); \
            if (MODE == 1) { S[0] += k0 * (v - S[0]); S[1] += k1 * (v - S[1]); S[2] += k2 * (v - S[2]); S[3] += k3 * (v - S[3]); } \
            else { v *= DT[bi][u]; const float aa = AS[bi][u]; S[0] = aa * S[0] + k0 * v; S[1] = aa * S[1] + k1 * v; S[2] = aa * S[2] + k2 * v; S[3] = aa * S[3] + k3 * v; } \
            o = (S[0] * q0 + S[1] * q1) + (S[2] * q2 + S[3] * q3); } \
        o += __shfl_xor(o, 4); o += __shfl_xor(o, 8); o += __shfl_xor(o, 16); o += __shfl_xor(o, 32); \
        if (lane < 4) op[tt * 768] = f2bf(o); } } while (0)
    SC_LOAD(0, 0);
    for (int b = 0; b < SEQ; b += 2 * U) {
        SC_LOAD(1, b + U);
        SC_COMP(0, b);
        if (b + 2 * U < SEQ) SC_LOAD(0, b + 2 * U);
        SC_COMP(1, b + U);
    }
#undef SC_LOAD
#undef SC_COMP
}
__device__ void scan_phase(const KArgs& a) {
    const bf16_t* proj = (const bf16_t*)(a.ws + WS_PROJ); const bf16_t* sc = (const bf16_t*)(a.ws + WS_SC); const float* dta = (const float*)(a.ws + WS_DTA);
    bf16_t* so = (bf16_t*)(a.ws + WS_SO);
    const int wave = tidx() >> 6, lane = tidx() & 63, esub = lane & 3, dgrp = lane >> 2;
    for (int item = wave * gdim() + bidx(); item < GS * 3 * 4 * 2 * 16; item += 8 * gdim()) {
        const int sp = item & 15, dir = (item >> 4) & 1, h = (item >> 5) & 3, s = (item >> 7) % GS, br = (item >> 7) / GS;
        const size_t t0 = (size_t)s * SEQ;
        const int e = sp * 4 + esub;
        bf16_t* op = so + ((size_t)dir * MG + t0) * 768 + br * 256 + h * 64 + e;
        if (br == 0) {
            const int grp = h >> 1;
            scan_chain<2>(sc + t0 * SCW + 384 + grp * 64 + dgrp * 4, sc + t0 * SCW + 256 + grp * 64 + dgrp * 4, sc + t0 * SCW + h * 64 + e, nullptr,
                          dta + t0 * 16 + dir * 4 + h, op, SCW, SCW, SCW, 0, dir, lane);
        } else if (br == 1) {
            scan_chain<0>(proj + t0 * NPROJ + C_GQ + h * 32 + dgrp * 2, proj + t0 * NPROJ + C_GK + h * 32 + dgrp * 2, proj + t0 * NPROJ + C_GV + h * 64 + e,
                          sc + t0 * SCW + 512 + dir * 128 + h * 32 + dgrp * 2, nullptr, op, NPROJ, NPROJ, NPROJ, SCW, dir, lane);
        } else {
            scan_chain<1>(proj + t0 * NPROJ + C_HQ + h * 64 + dgrp * 4, sc + t0 * SCW + 768 + dir * 256 + h * 64 + dgrp * 4, proj + t0 * NPROJ + C_HI + h * 64 + e,
                          nullptr, nullptr, op, NPROJ, SCW, NPROJ, 0, dir, lane);
        }
    }
}


constexpr int CP = 72;
constexpr int L_CB = 0, L_PART = 16640, L_REF = 18688, L_TOT = 18944, L_QP = 19200, L_KP = 28416, L_QI = 37632, L_VT = 46848, L_ST = 56064, L_ATT = 65280;
__device__ __forceinline__ f32x4 mm16(const bf16_t* A, const bf16_t* B, int mt, int nt, int K, int fr, int fq, f32x4 acc) {
    const bf16_t* ap = A + (mt * 16 + fr) * CP + fq * 8; const bf16_t* bp = B + (nt * 16 + fr) * CP + fq * 8;
    for (int k0 = 0; k0 < K; k0 += 32) { const bf16x8 av = *(const bf16x8*)(ap + k0); const bf16x8 bv = *(const bf16x8*)(bp + k0); acc = __builtin_amdgcn_mfma_f32_16x16x32_bf16(av, bv, acc, 0, 0, 0); }
    return acc;
}
__device__ __forceinline__ float* chain_state(unsigned char* ws, int br, int c16) {
    return br == 0 ? (float*)(ws + WS_TMP) + (size_t)c16 * 128 * 4096 : br == 2 ? (float*)(ws + WS_STH) + (size_t)c16 * 128 * 4096 : (float*)(ws + WS_STG) + (size_t)c16 * 128 * 2048;
}
template <bool PHASE_C>
__device__ void chunk_phase(const KArgs& a, int l, unsigned char* L) {
    const bf16_t* proj = (const bf16_t*)(a.ws + WS_PROJ); const bf16_t* sc = (const bf16_t*)(a.ws + WS_SC); const float* dta = (const float*)(a.ws + WS_DTA);
    bf16_t* so = (bf16_t*)(a.ws + WS_SO); float* dcb = (float*)(a.ws + WS_DC);
    const float* alog = a.in[22] + l * 8;
    float* cbS = (float*)(L + L_CB); float* partS = (float*)(L + L_PART); float* refS = (float*)(L + L_REF); float* totS = (float*)(L + L_TOT);
    bf16_t* qpS = (bf16_t*)(L + L_QP); bf16_t* kpS = (bf16_t*)(L + L_KP); bf16_t* qiS = (bf16_t*)(L + L_QI); bf16_t* vT = (bf16_t*)(L + L_VT); bf16_t* sT = (bf16_t*)(L + L_ST); bf16_t* attS = (bf16_t*)(L + L_ATT);
    const int tid = tidx(), row = tid >> 3, c8 = (tid & 7) * 8, wave = tid >> 6, lane = tid & 63, fr = lane & 15, fq = lane >> 4;
#pragma unroll 1
    for (int item = bidx(); item < 48 * 128; item += gdim()) {
        const int ci = item % 48, chunk = item / 48;
        const int br = ci >> 4, c16 = ci & 15, s = c16 >> 3, h = (c16 >> 1) & 3, dir = c16 & 1;
        const int dk = br == 1 ? 32 : 64;
        const size_t tok = (size_t)s * SEQ + chunk * 64 + row;
        const bf16_t *qp, *kp, *gp, *vp;
        if (br == 0) { const int grp = h >> 1; qp = sc + tok * SCW + 384 + grp * 64; kp = sc + tok * SCW + 256 + grp * 64; gp = kp; vp = sc + tok * SCW + h * 64; }
        else if (br == 1) { qp = proj + tok * NPROJ + C_GQ + h * 32; kp = proj + tok * NPROJ + C_GK + h * 32; gp = sc + tok * SCW + 512 + dir * 128 + h * 32; vp = proj + tok * NPROJ + C_GV + h * 64; }
        else { qp = proj + tok * NPROJ + C_HQ + h * 64; kp = sc + tok * SCW + 768 + dir * 256 + h * 64; gp = kp; vp = proj + tok * NPROJ + C_HI + h * 64; }
        const bool act = c8 < dk;
        u32x4 qv = {0u, 0u, 0u, 0u}, kv = {0u, 0u, 0u, 0u}, gv = {0u, 0u, 0u, 0u};
        const u32x4 vv = *(const u32x4*)(vp + c8);
        if (act) { kv = *(const u32x4*)(kp + c8); if (br == 1) gv = *(const u32x4*)(gp + c8); else gv = kv; if (PHASE_C) qv = *(const u32x4*)(qp + c8); }
        float dt = 1.f, gm = 0.f;
        if (br == 0) { dt = dta[tok * 16 + dir * 4 + h]; gm = -dt * __expf(alog[dir * 4 + h]); }
        float* stp = chain_state(a.ws, br, c16) + (size_t)chunk * 64 * dk;
        f32x4 sv0 = {0.f, 0.f, 0.f, 0.f}, sv1 = {0.f, 0.f, 0.f, 0.f};
        if (PHASE_C && act) { const f32x4* sp = (const f32x4*)(stp + (size_t)row * dk + c8); sv0 = sp[0]; sv1 = sp[1]; }
        float kf[8], gf[8];
        unpack8(kv, kf); unpack8(gv, gf);
        if (act) {
#pragma unroll
            for (int j = 0; j < 8; ++j) { const float g = br == 0 ? gm : fmaxf(__logf(fmaxf(1.0f - gf[j], 1e-30f)), -60.f); cbS[row * 65 + c8 + j] = g; }
        }
        __syncthreads();
        {
            const int d = tid & 63, part = tid >> 6; float loc[8]; float run = 0.f;
#pragma unroll
            for (int i = 0; i < 8; ++i) { const int u = part * 8 + i, t = dir ? 63 - u : u; run += cbS[t * 65 + d]; loc[i] = run; }
            partS[part * 64 + d] = run;
            __syncthreads();
            float off = 0.f;
#pragma unroll
            for (int p = 0; p < 8; ++p) off += (p < part) ? partS[p * 64 + d] : 0.f;
#pragma unroll
            for (int i = 0; i < 8; ++i) { const int u = part * 8 + i, t = dir ? 63 - u : u; cbS[t * 65 + d] = off + loc[i]; }
            if (part == 3) refS[d] = off + loc[7];
            if (part == 7) totS[d] = off + loc[7];
        }
        __syncthreads();
        {
            float vf[8]; unpack8(vv, vf);
#pragma unroll
            for (int j = 0; j < 8; ++j) vT[(c8 + j) * CP + row] = f2bf(vf[j] * dt);
            if (act) {
                if (PHASE_C) {
                    float qf[8], qo[8], ko[8], qi[8]; unpack8(qv, qf);
#pragma unroll
                    for (int j = 0; j < 8; ++j) { const float cb = cbS[row * 65 + c8 + j];
                        if (br == 0) { qo[j] = qf[j]; ko[j] = kf[j]; }
                        else { const float eq = fminf(fmaxf(cb - refS[c8 + j], -60.f), 60.f); qo[j] = qf[j] * __expf(eq); ko[j] = kf[j] * __expf(-eq); }
                        qi[j] = qf[j] * __expf(cb); }
                    *(u32x4*)(qpS + row * CP + c8) = pack8(qo); *(u32x4*)(kpS + row * CP + c8) = pack8(ko); *(u32x4*)(qiS + row * CP + c8) = pack8(qi);
                    float sf[8] = {sv0[0], sv0[1], sv0[2], sv0[3], sv1[0], sv1[1], sv1[2], sv1[3]};
                    *(u32x4*)(sT + row * CP + c8) = pack8(sf);
                } else {
#pragma unroll
                    for (int j = 0; j < 8; ++j) { const float cb = cbS[row * 65 + c8 + j]; qiS[(c8 + j) * CP + row] = f2bf(kf[j] * __expf(totS[c8 + j] - cb)); }
                }
            }
        }
        __syncthreads();
        if (PHASE_C) {
#pragma unroll
            for (int i = 0; i < 2; ++i) {
                const int ti = wave * 2 + i, mt = ti >> 2, nt = ti & 3;
                f32x4 acc = {0.f, 0.f, 0.f, 0.f};
                const bool live = dir ? (nt >= mt) : (nt <= mt);
                if (live) acc = mm16(qpS, kpS, mt, nt, dk, fr, fq, acc);
#pragma unroll
                for (int j = 0; j < 4; ++j) { const int t = mt * 16 + fq * 4 + j, sx = nt * 16 + fr; const bool valid = dir ? (sx >= t) : (sx <= t);
                    float v = acc[j];
                    if (br == 0) v *= __expf(fminf(cbS[t * 65] - cbS[sx * 65], 0.f));
                    attS[t * CP + sx] = f2bf(valid ? v : 0.f); }
            }
            __syncthreads();
#pragma unroll
            for (int i = 0; i < 2; ++i) {
                const int ti = wave * 2 + i, mt = ti >> 2, nt = ti & 3;
                f32x4 acc = {0.f, 0.f, 0.f, 0.f};
                acc = mm16(attS, vT, mt, nt, 64, fr, fq, acc);
                acc = mm16(qiS, sT, mt, nt, dk, fr, fq, acc);
                bf16_t* op = so + ((size_t)dir * MG + (size_t)s * SEQ + chunk * 64 + mt * 16 + fq * 4) * 768 + br * 256 + h * 64 + nt * 16 + fr;
#pragma unroll
                for (int j = 0; j < 4; ++j) op[(size_t)j * 768] = f2bf(acc[j]);
            }
        } else {
#pragma unroll
            for (int i = 0; i < 2; ++i) {
                const int ti = wave * 2 + i, mt = ti >> 2, nt = ti & 3;
                if (nt * 16 < dk) {
                    f32x4 acc = {0.f, 0.f, 0.f, 0.f};
                    acc = mm16(vT, qiS, mt, nt, 64, fr, fq, acc);
                    float* dp = stp + (size_t)(mt * 16 + fq * 4) * dk + nt * 16 + fr;
#pragma unroll
                    for (int j = 0; j < 4; ++j) dp[(size_t)j * dk] = acc[j];
                }
            }
            if (tid < dk) dcb[((size_t)ci * 128 + chunk) * 64 + tid] = __expf(totS[tid]);
        }
        __syncthreads();
    }
}
__device__ void chunk_carry(const KArgs& a) {
    const float* dcb = (const float*)(a.ws + WS_DC);
    const int nthr = gdim() * 512;
#pragma unroll 1
    for (int idx = bidx() * 512 + tidx(); idx < 16 * 4096 * 2 + 16 * 2048; idx += nthr) {
        int br, rem = idx;
        if (rem < 16 * 4096) br = 0; else if ((rem -= 16 * 4096) < 16 * 4096) br = 2; else { rem -= 16 * 4096; br = 1; }
        const int dk = br == 1 ? 32 : 64, per = 64 * dk;
        const int c16 = rem / per, ed = rem - c16 * per, d = ed & (dk - 1), dir = c16 & 1;
        float* st = chain_state(a.ws, br, c16) + ed;
        const float* dc = dcb + ((size_t)(br * 16 + c16) * 128) * 64 + d;
        float state = 0.f;
#pragma unroll 1
        for (int s0 = 0; s0 < 128; s0 += 8) {
            float tv[8], dv[8];
#pragma unroll
            for (int i = 0; i < 8; ++i) { const int c = dir ? 127 - (s0 + i) : s0 + i; tv[i] = st[(size_t)c * per]; dv[i] = dc[(size_t)c * 64]; }
#pragma unroll
            for (int i = 0; i < 8; ++i) { const int c = dir ? 127 - (s0 + i) : s0 + i; st[(size_t)c * per] = state; state = dv[i] * state + tv[i]; }
        }
    }
}

__device__ __forceinline__ void ld4(const bf16_t* p, float (&f)[4]) { const u32x2 w = *(const u32x2*)p; f[0] = bf_lo(w.x); f[1] = bf_hi(w.x); f[2] = bf_lo(w.y); f[3] = bf_hi(w.y); }
__device__ __forceinline__ void st4(bf16_t* p, const float (&f)[4]) { u32x2 w; w.x = pk_bf16(f[0], f[1]); w.y = pk_bf16(f[2], f[3]); *(u32x2*)p = w; }
__device__ void postscan_phase(const KArgs& a, int l) {
    const bf16_t* proj = (const bf16_t*)(a.ws + WS_PROJ); const bf16_t* sc = (const bf16_t*)(a.ws + WS_SC); const bf16_t* so = (const bf16_t*)(a.ws + WS_SO);
    bf16_t* ys = (bf16_t*)(a.ws + WS_YS);
    const float* mD = a.in[23] + l * 4; const float* mN = a.in[24] + l * 256; const float* gN = a.in[27] + l * 64; const float* hN = a.in[29] + l * 64;
    const int wave = tidx() >> 6, lane = tidx() & 63, c4 = lane * 4;
    for (int tok = bidx() * 8 + wave; tok < MG; tok += gdim() * 8) {
        const bf16_t* sf = so + (size_t)tok * 768; const bf16_t* sb = so + ((size_t)MG + tok) * 768; const bf16_t* row = proj + (size_t)tok * NPROJ;
        float of[4], ob[4], g[4], y[4];
        {
            float mx[4]; ld4(sf + c4, of); ld4(sb + c4, ob); ld4(sc + (size_t)tok * SCW + c4, mx); ld4(row + C_M2Z + c4, g);
            const float Dh = mD[lane >> 4]; float ss = 0.f;
#pragma unroll
            for (int j = 0; j < 4; ++j) { y[j] = (of[j] + ob[j] + Dh * mx[j]) * siluf_(g[j]); ss += y[j] * y[j]; }
            ss = wave_sum(ss); const float rs = rsqrtf(ss * (1.0f / 256.0f) + EPS);
#pragma unroll
            for (int j = 0; j < 4; ++j) y[j] *= rs * mN[c4 + j];
            st4(ys + (size_t)tok * 1024 + 256 + c4, y);
        }
        {
            ld4(sf + 256 + c4, of); ld4(sb + 256 + c4, ob); ld4(row + C_GG + c4, g); float ss = 0.f;
#pragma unroll
            for (int j = 0; j < 4; ++j) { y[j] = (of[j] + ob[j]) * 0.17677669529663687f; ss += y[j] * y[j]; }
            ss += __shfl_xor(ss, 1); ss += __shfl_xor(ss, 2); ss += __shfl_xor(ss, 4); ss += __shfl_xor(ss, 8);
            const float rs = rsqrtf(ss * (1.0f / 64.0f) + EPS);
#pragma unroll
            for (int j = 0; j < 4; ++j) y[j] = y[j] * rs * gN[(c4 & 63) + j] * siluf_(g[j]);
            st4(ys + (size_t)tok * 1024 + 512 + c4, y);
        }
        {
            ld4(sf + 512 + c4, of); ld4(sb + 512 + c4, ob); ld4(row + C_HGG + c4, g); float ss = 0.f;
#pragma unroll
            for (int j = 0; j < 4; ++j) { y[j] = (of[j] + ob[j]) * 0.125f; ss += y[j] * y[j]; }
            ss += __shfl_xor(ss, 1); ss += __shfl_xor(ss, 2); ss += __shfl_xor(ss, 4); ss += __shfl_xor(ss, 8);
            const float rs = rsqrtf(ss * (1.0f / 64.0f) + EPS);
#pragma unroll
            for (int j = 0; j < 4; ++j) y[j] = y[j] * rs * hN[(c4 & 63) + j] * siluf_(g[j]);
            st4(ys + (size_t)tok * 1024 + 768 + c4, y);
        }
    }
}

__global__ void __launch_bounds__(512) hybrid_fwd(KArgs a) {
    extern __shared__ __attribute__((aligned(16))) unsigned char lds_raw[];
    LAS unsigned char* lds = (LAS unsigned char*)lds_raw;
    cg::grid_group grid = cg::this_grid();
    unsigned char* ws = a.ws;
    const int lo = a.ph_lo, hi = a.ph_hi;
    const int G = gdim(), bid = bidx();
#pragma unroll 1
    for (int pc = lo; pc < hi; ++pc) {
        const int l = pc / 56, r = pc - l * 56;
        bf16_t* XN = (bf16_t*)(ws + WS_XN); bf16_t* PROJ = (bf16_t*)(ws + WS_PROJ); bf16_t* ACT = PROJ; bf16_t* YB = PROJ;
        bf16_t* YS = (bf16_t*)(ws + WS_YS); bf16_t* TMP = (bf16_t*)(ws + WS_TMP); bf16_t* MERGED = (bf16_t*)(ws + WS_SO);
        if (r == 0) { prep_weights(a, l, (float*)lds_raw); filter_hidden(a, l, (float*)lds_raw); }
        else if (r == 1) { filter_spectra(a, l, (float2*)lds_raw, (float*)(lds_raw + 131072)); }
        else {
            const int g = (r - 2) / 18, j = (r - 2) - g * 18;
            float* xg = a.out + (size_t)g * MG * 1024;
            if (j == 0 || j == 3 || j == 14 || j == 17) {
                const float* xsrc = xg; float* xdst = xg; const bf16_t* tmp = TMP; const float* wpost = nullptr; const float* wpre = nullptr; float scale = 0.5f; bf16_t* xn = XN;
                if (j == 0) { xsrc = (l == 0) ? ((g < 2) ? a.in[0] + (size_t)g * MG * 1024 : a.in[1]) : xg; xdst = (l == 0) ? xg : nullptr; tmp = nullptr; wpre = a.in[2] + l * 1024; }
                else if (j == 3) { wpost = a.in[3] + l * 1024; wpre = a.in[6] + l * 1024; }
                else if (j == 14) { wpost = a.in[7] + l * 1024; wpre = a.in[32] + l * 1024; scale = 1.0f; }
                else { wpost = a.in[33] + l * 1024; xn = nullptr; }
                norm_rows(xsrc, xdst, tmp, wpost, scale, wpre, xn);
            } else if (j == 1 || j == 15) {
                pg8::Gemm gm{XN, (const bf16_t*)(ws + (j == 1 ? WS_GU1 : WS_GU2)), MG, 5632, 1024, 1024, 1024}; pg8::StaticOrder S; S.init(MG, 5632, G, bid); pg8::EpiSwiGLU E{ACT, DFF}; pg8::gemm_phase(lds, gm, S, E);
            } else if (j == 2 || j == 4 || j == 11 || j == 13 || j == 16) {
                const bf16_t* A = ACT; const bf16_t* Bt = (const bf16_t*)(ws + WS_DN1); int N = 1024, K = DFF, lda = DFF, ldc = 1024, reps = 1; bf16_t* O = TMP;
                if (j == 16) Bt = (const bf16_t*)(ws + WS_DN2);
                else if (j == 4) { A = XN; Bt = (const bf16_t*)(ws + WS_INT); N = NPROJ; K = 1024; lda = 1024; O = PROJ; ldc = NPROJ; }
                else if (j == 11) { A = YS; Bt = (const bf16_t*)(ws + WS_BR); K = 256; lda = 1024; O = YB; ldc = 4096; reps = 4; }
                else if (j == 13) { A = MERGED; Bt = (const bf16_t*)(ws + WS_OUT); K = 1024; lda = 1024; }
#pragma unroll 1
                for (int nb = 0; nb < reps; ++nb) {
                    pg8::Gemm gm{A + nb * 256, Bt + (size_t)nb * 1024 * 256, MG, N, K, lda, K}; pg8::StaticOrder S; S.init(MG, N, G, bid); pg8::EpiBf16 E{O + nb * 1024, ldc}; pg8::gemm_phase(lds, gm, S, E);
                }
            } else if (j == 12) {
                pg8::Gemm gm{XN, (const bf16_t*)(ws + WS_GT), MG, 4096, 1024, 1024, 1024}; pg8::StaticOrder S; S.init(MG, 4096, G, bid); pg8::EpiMerge E{YB, MERGED}; pg8::gemm_phase(lds, gm, S, E);
            } else if (j == 5) prescan_phase(a, l);
            else if (j == 6) hyena_phase(a, l, (float2*)lds_raw);
            else if (j == 7) chunk_phase<false>(a, l, lds_raw);
            else if (j == 8) chunk_carry(a);
            else if (j == 9) chunk_phase<true>(a, l, lds_raw);
            else postscan_phase(a, l);
        }
        if (pc + 1 < hi) grid.sync();
    }
}
constexpr int N_PHASES = 2 * (2 + NGRP * 18);

extern "C" void kernel_launch(void* const* d_in, const int* in_sizes, int n_in, void* d_out, int out_size, void* d_ws, size_t ws_size, hipStream_t stream) {
    static int grid = 0;
    if (grid == 0) {
        if (n_in != 36 || ws_size < WS_END) { fprintf(stderr, "kernel_launch: need 36 inputs and %zu bytes of workspace (got %d, %zu)\n", (size_t)WS_END, n_in, ws_size); grid = -1; return; }
        int dev = 0, cus = 0, per_cu = 0;
        (void)hipGetDevice(&dev); (void)hipDeviceGetAttribute(&cus, hipDeviceAttributeMultiprocessorCount, dev);
        if (hipFuncSetAttribute((const void*)hybrid_fwd, hipFuncAttributeMaxDynamicSharedMemorySize, LDS_BYTES) != hipSuccess) { fprintf(stderr, "kernel_launch: hipFuncSetAttribute failed\n"); grid = -1; return; }
        if (hipOccupancyMaxActiveBlocksPerMultiprocessor(&per_cu, (const void*)hybrid_fwd, 512, LDS_BYTES) != hipSuccess || per_cu < 1) { fprintf(stderr, "kernel_launch: occupancy query gave %d\n", per_cu); per_cu = 1; }
        (void)hipGetLastError();
        grid = cus * 1;
    }
    if (grid < 0) return;
    KArgs a{};
    for (int i = 0; i < 36; ++i) a.in[i] = (const float*)d_in[i];
    a.out = (float*)d_out; a.ws = (unsigned char*)d_ws; a.ph_lo = 0; a.ph_hi = N_PHASES;
    void* args[] = {&a};
    hipError_t e = hipLaunchCooperativeKernel((const void*)hybrid_fwd, dim3(grid), dim3(512), args, LDS_BYTES, stream);
    if (e != hipSuccess) fprintf(stderr, "cooperative launch failed: %s (grid %d)\n", hipGetErrorString(e), grid);
}
```

```cpp
#include <hip/hip_runtime.h>
#include <hip/hip_cooperative_groups.h>
#include <cstdio>
namespace cg = cooperative_groups;

#define LAS __attribute__((address_space(3)))
typedef unsigned short bf16_t;
typedef short bf16x8 __attribute__((ext_vector_type(8)));
typedef float f32x4 __attribute__((ext_vector_type(4)));
typedef unsigned u32x4 __attribute__((ext_vector_type(4)));
typedef unsigned u32x2 __attribute__((ext_vector_type(2)));

constexpr int DM = 1024, SEQ = 8192, DFF = 2816;
constexpr int GS = 2, MG = GS * SEQ, NGRP = 3;
constexpr int NPROJ = 3840, NIN = 7720, NNG = 3624;
constexpr int SCW = 1280;
constexpr int FN = 16384;
constexpr int SPP = 8200;
constexpr float EPS = 1e-6f;
constexpr int C_HY = 0, C_M2Z = 768, C_XBC = 1024, C_DT = 1536, C_GQ = 1544, C_GK = 1672, C_GV = 1800, C_GA = 2056, C_GG = 2088,
              C_HQ = 2344, C_HF = 2600, C_HI = 3112, C_HGG = 3368;
constexpr size_t WS_GU1 = 0;
constexpr size_t WS_DN1 = WS_GU1 + (size_t)5632 * 1024 * 2;
constexpr size_t WS_INT = WS_DN1 + (size_t)1024 * 2816 * 2;
constexpr size_t WS_GT  = WS_INT + (size_t)NPROJ * 1024 * 2;
constexpr size_t WS_BR  = WS_GT + (size_t)4096 * 1024 * 2;
constexpr size_t WS_OUT = WS_BR + (size_t)4 * 1024 * 256 * 2;
constexpr size_t WS_GU2 = WS_OUT + (size_t)1024 * 1024 * 2;
constexpr size_t WS_DN2 = WS_GU2 + (size_t)5632 * 1024 * 2;
constexpr size_t WS_H2  = WS_DN2 + (size_t)1024 * 2816 * 2;
constexpr size_t WS_SP  = WS_H2 + (size_t)8192 * 64 * 4;
constexpr size_t WS_XN  = WS_SP + (size_t)256 * SPP * 16;
constexpr size_t WS_PROJ = WS_XN + (size_t)MG * 1024 * 2;
constexpr size_t WS_SC  = WS_PROJ + (size_t)MG * NPROJ * 2;
constexpr size_t WS_DTA = WS_SC + (size_t)MG * SCW * 2;
constexpr size_t WS_SO  = WS_DTA + (size_t)MG * 16 * 4;
constexpr size_t WS_YS  = WS_SO + (size_t)2 * MG * 768 * 2;
constexpr size_t WS_TMP = WS_YS + (size_t)MG * 1024 * 2;
constexpr size_t WS_STH = WS_TMP + (size_t)MG * 1024 * 2;
constexpr size_t WS_STG = WS_STH + (size_t)16 * 128 * 64 * 64 * 4;
constexpr size_t WS_DC  = WS_STG + (size_t)16 * 128 * 64 * 32 * 4;
constexpr size_t WS_BAR = WS_DC + (size_t)3 * 16 * 128 * 64 * 4;
constexpr size_t WS_END = WS_BAR + (size_t)16384;
constexpr int LDS_BYTES = 131072 + 4096;

struct KArgs { const float* in[36]; float* out; unsigned char* ws; int ph_lo, ph_hi; };

__device__ __forceinline__ float bf_lo(unsigned w) { return __uint_as_float(w << 16); }
__device__ __forceinline__ float bf_hi(unsigned w) { return __uint_as_float(w & 0xffff0000u); }
__device__ __forceinline__ float bf2f(bf16_t b) { return __uint_as_float(((unsigned)b) << 16); }
__device__ __forceinline__ bf16_t f2bf(float f) { unsigned u = __float_as_uint(f); u += 0x7FFFu + ((u >> 16) & 1u); return (bf16_t)(u >> 16); }
__device__ __forceinline__ unsigned pk_bf16(float lo, float hi) { unsigned r; asm volatile("v_cvt_pk_bf16_f32 %0, %1, %2" : "=v"(r) : "v"(lo), "v"(hi)); return r; }
__device__ __forceinline__ float sigmoidf_(float x) { return __builtin_amdgcn_rcpf(1.0f + __expf(-x)); }
__device__ __forceinline__ float siluf_(float x) { return x * sigmoidf_(x); }
__device__ __forceinline__ float softplusf_(float x) { return fmaxf(x, 0.f) + __logf(1.0f + __expf(-fabsf(x))); }
__device__ __forceinline__ float sin_rad(float x) { return __builtin_amdgcn_sinf(x * 0.15915494309189535f); }
__device__ __forceinline__ float wave_sum(float v) {
#pragma unroll
    for (int o = 32; o >= 1; o >>= 1) v += __shfl_xor(v, o);
    return v;
}


__device__ __forceinline__ int tidx() { int t = threadIdx.x; asm volatile("" : "+v"(t)); return t; }
__device__ __forceinline__ int bidx() { int b = blockIdx.x; asm volatile("" : "+s"(b)); return b; }
__device__ __forceinline__ int gdim() { int g = gridDim.x; asm volatile("" : "+s"(g)); return g; }

namespace pg8 {
constexpr int BM = 256, BK = 64, HALF = 128, HTB = HALF * BK * 2, NXCD = 8, WGM = 8;
__device__ __forceinline__ int lds_byte(int r, int c) { const int st = (r >> 4) * 2 + (c >> 5), rr = r & 15, cc = c & 31, ob = rr * 64 + cc * 2; return st * 1024 + (ob ^ (((ob >> 9) & 1) << 5)); }
__device__ __forceinline__ void stage_rc(int b, int& R, int& C) { const int st = b / 1024, sb = b % 1024, swz = sb ^ (((sb >> 9) & 1) << 5); R = (st >> 1) * 16 + swz / 64; C = (st & 1) * 32 + (swz % 64) / 2; }
__device__ __forceinline__ int perm32(int rho) { const int n = rho >> 4, i = rho & 15; return 8 * (i >> 2) + 4 * n + (i & 3); }
struct Unit { int pm, pn; };
struct Gemm { const bf16_t* A; const bf16_t* Bt; int M, N, K, lda, ldb; };
struct StaticOrder {
    int nM, nN, nwg, G, c;
    __device__ void init(int M, int N, int G_, int c_) { nM = M / BM; nN = N / BM; nwg = nM * nN; G = G_; c = c_; }
    __device__ bool next(int i, Unit& u) const {
        const long L = (long)i * G + c; if (L >= nwg) return false;
        int wgid = (int)L; { const int q = nwg / NXCD, r = nwg % NXCD, xcd = wgid % NXCD, off = wgid / NXCD; wgid = (xcd < r ? xcd * (q + 1) : r * (q + 1) + (xcd - r) * q) + off; }
        const int nig = WGM * nN, gid = wgid / nig, fm = gid * WGM, gsz = (nM - fm) < WGM ? (nM - fm) : WGM;
        u.pm = fm + ((wgid % nig) % gsz); u.pn = (wgid % nig) / gsz; return true;
    }
};

template <class Epi>
__device__ __forceinline__ void gemm_phase(LAS unsigned char* lds, const Gemm g, const StaticOrder& S, const Epi& E) {
    const int tid = tidx(), wid = __builtin_amdgcn_readfirstlane(tid >> 6), lane = tid & 63, wr = wid >> 2, wc = wid & 3, fr = lane & 15, fq = lane >> 4;
    const int K = g.K, nt = K / BK;
    unsigned voffA[2], voffB[2];
#pragma unroll
    for (int i = 0; i < 2; ++i) { int R, C; stage_rc(tid * 16 + i * 8192, R, C); const int Rb = Epi::PERM ? ((R & ~31) + perm32(R & 31)) : R;
        voffA[i] = (unsigned)(R * g.lda + C) * 2u; voffB[i] = (unsigned)(Rb * g.ldb + C) * 2u; }
    const size_t kstep = (size_t)(BK * 2);
    const size_t hstepA = (size_t)HALF * g.lda * 2, hstepB = (size_t)HALF * g.ldb * 2;
    const size_t tstepA = 2 * hstepA, tstepB = 2 * hstepB;
    const unsigned ldsw = (unsigned)wid * 1024u;
    const int aoff = lds_byte(wr * 64 + fr, fq * 8), boff = lds_byte(wc * 32 + fr, fq * 8);
#define PG8_SA(b, h) (((b) * 2 + (h)) * HTB)
#define PG8_SB(b, h) ((4 + (b) * 2 + (h)) * HTB)
#define PG8_STAGE(bufoff, gbase, voff) do { _Pragma("unroll") for (int _i = 0; _i < 2; ++_i) \
        __builtin_amdgcn_global_load_lds((const unsigned*)((const char*)(gbase) + (voff)[_i]), (LAS unsigned*)(lds + (bufoff) + ldsw + _i * 8192), 16, 0, 0); } while (0)
#define PG8_LDA(dst, b, h) do { _Pragma("unroll") for (int m = 0; m < 4; ++m) _Pragma("unroll") for (int k = 0; k < 2; ++k) dst[m][k] = *(const LAS bf16x8*)(lds + PG8_SA(b, h) + aoff + m * 2048 + k * 1024); } while (0)
#define PG8_LDB(dst, b, h) do { _Pragma("unroll") for (int n = 0; n < 2; ++n) _Pragma("unroll") for (int k = 0; k < 2; ++k) dst[n][k] = *(const LAS bf16x8*)(lds + PG8_SB(b, h) + boff + n * 2048 + k * 1024); } while (0)
#define PG8_MMA(ai, bj, At, Bt) do { __builtin_amdgcn_s_setprio(1); _Pragma("unroll") for (int m = 0; m < 4; ++m) _Pragma("unroll") for (int n = 0; n < 2; ++n) _Pragma("unroll") for (int k = 0; k < 2; ++k) \
        acc[ai][bj][m][n] = __builtin_amdgcn_mfma_f32_16x16x32_bf16(Bt[n][k], At[m][k], acc[ai][bj][m][n], 0, 0, 0); __builtin_amdgcn_s_setprio(0); } while (0)
#define PG8_WAIT_V(n) asm volatile("s_waitcnt vmcnt(" #n ")" ::: "memory")
#define PG8_WAIT_L(n) asm volatile("s_waitcnt lgkmcnt(" #n ")" ::: "memory")
#define PG8_BAR __builtin_amdgcn_s_barrier()
#define PG8_SCHED __builtin_amdgcn_sched_barrier(0)
    Unit cur, nxt; int ui = 0;
    if (!S.next(0, cur)) return;
    f32x4 acc[2][2][4][2];
#pragma unroll
    for (int a = 0; a < 2; ++a)
#pragma unroll
        for (int b = 0; b < 2; ++b)
#pragma unroll
            for (int m = 0; m < 4; ++m)
#pragma unroll
                for (int n = 0; n < 2; ++n) acc[a][b][m][n] = (f32x4){0.f, 0.f, 0.f, 0.f};
    bf16x8 At[4][2], B0[2][2], B1[2][2];
    const char* cA = (const char*)g.A + (size_t)cur.pm * tstepA; const char* cB = (const char*)g.Bt + (size_t)cur.pn * tstepB;
    PG8_STAGE(PG8_SB(0, 0), cB, voffB); PG8_STAGE(PG8_SA(0, 0), cA, voffA); PG8_STAGE(PG8_SB(0, 1), cB + hstepB, voffB); PG8_STAGE(PG8_SA(0, 1), cA + hstepA, voffA);
    if (wr == 1) PG8_BAR;
    PG8_WAIT_V(4); PG8_BAR;
    PG8_STAGE(PG8_SB(1, 0), cB + kstep, voffB); PG8_STAGE(PG8_SA(1, 0), cA + kstep, voffA); PG8_STAGE(PG8_SB(1, 1), cB + hstepB + kstep, voffB);
    PG8_WAIT_V(6); PG8_BAR;
    for (;;) {
        const bool has_next = S.next(ui + 1, nxt);
        const char* nA = has_next ? (const char*)g.A + (size_t)nxt.pm * tstepA : cA; const char* nB = has_next ? (const char*)g.Bt + (size_t)nxt.pn * tstepB : cB;
        for (int t = 0; t < nt; t += 2) {
            const bool last = (t == nt - 2);
            const char* a1 = cA + (size_t)(t + 1) * kstep;
            const char* a2 = last ? nA : cA + (size_t)(t + 2) * kstep; const char* b2 = last ? nB : cB + (size_t)(t + 2) * kstep;
            const char* a3 = a2 + kstep; const char* b3 = b2 + kstep;
            PG8_LDB(B0, 0, 0); PG8_SCHED; PG8_LDA(At, 0, 0); PG8_STAGE(PG8_SA(1, 1), a1 + hstepA, voffA);
            PG8_WAIT_L(8); PG8_BAR; PG8_WAIT_L(0); PG8_MMA(0, 0, At, B0); PG8_BAR; PG8_SCHED;
            PG8_LDB(B1, 0, 1); PG8_STAGE(PG8_SB(0, 0), b2, voffB);
            PG8_BAR; PG8_WAIT_L(0); PG8_MMA(0, 1, At, B1); PG8_BAR;
            PG8_LDA(At, 0, 1); PG8_STAGE(PG8_SA(0, 0), a2, voffA);
            PG8_BAR; PG8_WAIT_L(0); PG8_MMA(1, 0, At, B0); PG8_BAR; PG8_SCHED;
            PG8_STAGE(PG8_SB(0, 1), b2 + hstepB, voffB);
            PG8_WAIT_V(6); PG8_BAR; PG8_MMA(1, 1, At, B1); PG8_BAR;
            PG8_LDB(B0, 1, 0); PG8_SCHED; PG8_LDA(At, 1, 0); PG8_STAGE(PG8_SA(0, 1), a2 + hstepA, voffA);
            PG8_WAIT_L(8); PG8_BAR; PG8_WAIT_L(0); PG8_MMA(0, 0, At, B0); PG8_BAR; PG8_SCHED;
            PG8_LDB(B1, 1, 1); PG8_STAGE(PG8_SB(1, 0), b3, voffB);
            PG8_BAR; PG8_WAIT_L(0); PG8_MMA(0, 1, At, B1); PG8_BAR;
            PG8_LDA(At, 1, 1); PG8_STAGE(PG8_SA(1, 0), a3, voffA);
            PG8_BAR; PG8_WAIT_L(0); PG8_MMA(1, 0, At, B0); PG8_BAR; PG8_SCHED;
            PG8_STAGE(PG8_SB(1, 1), b3 + hstepB, voffB);
            PG8_WAIT_V(6); PG8_BAR; PG8_MMA(1, 1, At, B1); PG8_BAR;
        }
        E(acc, cur, wr, wc, fr, fq);
        if (!has_next) break;
#pragma unroll
        for (int a = 0; a < 2; ++a)
#pragma unroll
            for (int b = 0; b < 2; ++b)
#pragma unroll
                for (int m = 0; m < 4; ++m)
#pragma unroll
                    for (int n = 0; n < 2; ++n) acc[a][b][m][n] = (f32x4){0.f, 0.f, 0.f, 0.f};
        cur = nxt; cA = nA; cB = nB; ++ui;
    }
    PG8_WAIT_V(0);
    if (wr == 0) PG8_BAR;
    PG8_BAR;
#undef PG8_SA
#undef PG8_SB
#undef PG8_STAGE
#undef PG8_LDA
#undef PG8_LDB
#undef PG8_MMA
#undef PG8_WAIT_V
#undef PG8_WAIT_L
#undef PG8_BAR
#undef PG8_SCHED
}

struct EpiBf16 {
    static constexpr bool PERM = true;
    bf16_t* O; int ldc;
    __device__ __forceinline__ void operator()(const f32x4 (&acc)[2][2][4][2], const Unit& u, int wr, int wc, int fr, int fq) const {
        const int row0 = u.pm * BM + wr * 64 + fr, col0 = u.pn * BM + wc * 32 + 8 * fq;
#pragma unroll
        for (int ai = 0; ai < 2; ++ai)
#pragma unroll
            for (int m = 0; m < 4; ++m) { bf16_t* rowp = O + (size_t)(row0 + ai * HALF + m * 16) * ldc + col0;
#pragma unroll
                for (int bj = 0; bj < 2; ++bj) { const f32x4 v0 = acc[ai][bj][m][0], v1 = acc[ai][bj][m][1];
                    u32x4 w; w.x = pk_bf16(v0[0], v0[1]); w.y = pk_bf16(v0[2], v0[3]); w.z = pk_bf16(v1[0], v1[1]); w.w = pk_bf16(v1[2], v1[3]);
                    *(u32x4*)(rowp + bj * HALF) = w; } }
    }
};
struct EpiSwiGLU {
    static constexpr bool PERM = true;
    bf16_t* O; int ldc;
    __device__ __forceinline__ void operator()(const f32x4 (&acc)[2][2][4][2], const Unit& u, int wr, int wc, int fr, int fq) const {
        const int row0 = u.pm * BM + wr * 64 + fr, col0 = u.pn * HALF + wc * 32 + 8 * fq;
#pragma unroll
        for (int ai = 0; ai < 2; ++ai)
#pragma unroll
            for (int m = 0; m < 4; ++m) { bf16_t* rowp = O + (size_t)(row0 + ai * HALF + m * 16) * ldc + col0;
                const f32x4 g0 = acc[ai][0][m][0], g1 = acc[ai][0][m][1], u0 = acc[ai][1][m][0], u1 = acc[ai][1][m][1];
                float r[8];
#pragma unroll
                for (int j = 0; j < 4; ++j) { r[j] = siluf_(g0[j]) * u0[j]; r[4 + j] = siluf_(g1[j]) * u1[j]; }
                u32x4 w; w.x = pk_bf16(r[0], r[1]); w.y = pk_bf16(r[2], r[3]); w.z = pk_bf16(r[4], r[5]); w.w = pk_bf16(r[6], r[7]);
                *(u32x4*)rowp = w; }
    }
};
struct EpiMerge {
    static constexpr bool PERM = false;
    const bf16_t* Y; bf16_t* O;
    __device__ __forceinline__ void operator()(const f32x4 (&acc)[2][2][4][2], const Unit& u, int wr, int wc, int fr, int fq) const {
        const int row0 = u.pm * BM + wr * 64 + fr, c0 = u.pn * 64 + wc * 16 + 4 * fq;
#pragma unroll
        for (int ai = 0; ai < 2; ++ai)
#pragma unroll
            for (int m = 0; m < 4; ++m) { const size_t row = (size_t)(row0 + ai * HALF + m * 16);
                float s[4] = {0.f, 0.f, 0.f, 0.f};
#pragma unroll
                for (int bj = 0; bj < 2; ++bj)
#pragma unroll
                    for (int n = 0; n < 2; ++n) { const u32x2 y = *(const u32x2*)(Y + row * 4096 + (2 * bj + n) * 1024 + c0); const f32x4 a = acc[ai][bj][m][n];
                        s[0] += sigmoidf_(a[0]) * bf_lo(y.x); s[1] += sigmoidf_(a[1]) * bf_hi(y.x); s[2] += sigmoidf_(a[2]) * bf_lo(y.y); s[3] += sigmoidf_(a[3]) * bf_hi(y.y); }
                u32x2 w; w.x = pk_bf16(s[0], s[1]); w.y = pk_bf16(s[2], s[3]);
                *(u32x2*)(O + row * 1024 + c0) = w; }
    }
};
}

__device__ __forceinline__ int srccol(int kind, int n) {
    if (kind == 0) { const int pn = n >> 8, w = n & 255; return w < 128 ? pn * 128 + w : DFF + pn * 128 + (w - 128); }
    if (kind == 1) return n;
    if (kind == 2) return n < NNG ? n : -1;
    const int pn = n >> 8, T = n & 255, bj = T >> 7, wc = (T >> 5) & 3, nn = (T >> 4) & 1, fq = (T >> 2) & 3, j = T & 3;
    return NNG + (2 * bj + nn) * 1024 + 64 * pn + 16 * wc + 4 * fq + j;
}
__device__ void prep_weights(const KArgs& a, int l, float* tile) {
    unsigned char* ws = a.ws; const int tid = tidx();
    for (int tix = bidx(); tix < 6720; tix += gdim()) {
        int tl = tix, kind, K, ld, NT; const float* src; bf16_t* dst;
        if (tl < 1408) { kind = 0; src = a.in[4] + (size_t)l * 1024 * 5632; dst = (bf16_t*)(ws + WS_GU1); K = 1024; ld = 5632; NT = 88; }
        else if ((tl -= 1408) < 704) { kind = 1; src = a.in[5] + (size_t)l * DFF * 1024; dst = (bf16_t*)(ws + WS_DN1); K = DFF; ld = 1024; NT = 16; }
        else if ((tl -= 704) < 960) { kind = 2; src = a.in[8] + (size_t)l * 1024 * NIN; dst = (bf16_t*)(ws + WS_INT); K = 1024; ld = NIN; NT = 60; }
        else if ((tl -= 960) < 1024) { kind = 3; src = a.in[8] + (size_t)l * 1024 * NIN; dst = (bf16_t*)(ws + WS_GT); K = 1024; ld = NIN; NT = 64; }
        else if ((tl -= 1024) < 256) { kind = 1; const int nb = tl >> 6; tl &= 63; src = a.in[30] + (size_t)(l * 4 + nb) * 256 * 1024; dst = (bf16_t*)(ws + WS_BR) + (size_t)nb * 1024 * 256; K = 256; ld = 1024; NT = 16; }
        else if ((tl -= 256) < 256) { kind = 1; src = a.in[31] + (size_t)l * 1024 * 1024; dst = (bf16_t*)(ws + WS_OUT); K = 1024; ld = 1024; NT = 16; }
        else if ((tl -= 256) < 1408) { kind = 0; src = a.in[34] + (size_t)l * 1024 * 5632; dst = (bf16_t*)(ws + WS_GU2); K = 1024; ld = 5632; NT = 88; }
        else { tl -= 1408; kind = 1; src = a.in[35] + (size_t)l * DFF * 1024; dst = (bf16_t*)(ws + WS_DN2); K = DFF; ld = 1024; NT = 16; }
        const int tn = tl % NT, tk = tl / NT, n0 = tn * 64, k0 = tk * 64;
        const int cidx = tid & 63, r = tid >> 6;
        const int sc = srccol(kind, n0 + cidx);
#pragma unroll
        for (int rr = 0; rr < 8; ++rr) { const int kl = rr * 8 + r; tile[kl * 65 + cidx] = sc >= 0 ? src[(size_t)(k0 + kl) * ld + sc] : 0.f; }
        __syncthreads();
#pragma unroll
        for (int rr = 0; rr < 8; ++rr) { const int nl = rr * 8 + r; dst[(size_t)(n0 + nl) * K + k0 + cidx] = f2bf(tile[cidx * 65 + nl]); }
        __syncthreads();
    }
}
__device__ void filter_hidden(const KArgs& a, int l, float* h1s) {
    const int tid = tidx(), p = tid >> 6, u = tid & 63;
    const float* w1 = a.in[11] + (size_t)l * 33 * 64; const float* b1 = a.in[12] + l * 64; const float* w2 = a.in[13] + (size_t)l * 64 * 64; const float* b2 = a.in[14] + l * 64;
    const float* fr = a.in[15] + (size_t)l * 128;
    float* H2 = (float*)(a.ws + WS_H2);
    for (int pb = bidx(); pb < 1024; pb += gdim()) {
        const int t = pb * 8 + p; const float tp = (float)t * (1.0f / 8191.0f);
        float acc = b1[u] + tp * w1[u];
#pragma unroll
        for (int j = 0; j < 16; ++j) { const float band = 1e-4f + (float)j * ((15.0f - 1e-4f) / 15.0f);
            float rev = (band * (float)t) * (1.0f / 8192.0f); rev -= floorf(rev);
            const float c = __builtin_amdgcn_cosf(rev), s = __builtin_amdgcn_sinf(rev);
            acc += c * w1[(1 + j) * 64 + u] - s * w1[(17 + j) * 64 + u]; }
        h1s[p * 64 + u] = sin_rad(fr[u] * acc);
        __syncthreads();
        float acc2 = b2[u];
#pragma unroll 8
        for (int k = 0; k < 64; ++k) acc2 += h1s[p * 64 + k] * w2[k * 64 + u];
        H2[(size_t)t * 64 + u] = sin_rad(fr[64 + u] * acc2);
        __syncthreads();
    }
}

__device__ __forceinline__ void fft_fwd(float2* X, int tid) {
#pragma unroll 1
    for (int h = FN / 2; h >= 1; h >>= 1) {
        const float inv2h = 0.5f / (float)h;
#pragma unroll 2
        for (int b = tid; b < FN / 2; b += 512) {
            const int j = b & (h - 1), i = ((b - j) << 1) + j;
            const float2 x0 = X[i], x1 = X[i + h];
            const float f = -(float)j * inv2h;
            const float cw = __builtin_amdgcn_cosf(f), sw = __builtin_amdgcn_sinf(f);
            const float dx = x0.x - x1.x, dy = x0.y - x1.y;
            X[i] = make_float2(x0.x + x1.x, x0.y + x1.y);
            X[i + h] = make_float2(dx * cw - dy * sw, dx * sw + dy * cw);
        }
        __syncthreads();
    }
}
__device__ __forceinline__ void fft_inv(float2* X, int tid) {
#pragma unroll 1
    for (int h = 1; h <= FN / 2; h <<= 1) {
        const float inv2h = 0.5f / (float)h;
#pragma unroll 2
        for (int b = tid; b < FN / 2; b += 512) {
            const int j = b & (h - 1), i = ((b - j) << 1) + j;
            const float2 x0 = X[i], x1 = X[i + h];
            const float f = (float)j * inv2h;
            const float cw = __builtin_amdgcn_cosf(f), sw = __builtin_amdgcn_sinf(f);
            const float cx = x1.x * cw - x1.y * sw, cy = x1.x * sw + x1.y * cw;
            X[i] = make_float2(x0.x + cx, x0.y + cy);
            X[i + h] = make_float2(x0.x - cx, x0.y - cy);
        }
        __syncthreads();
    }
}
__device__ __forceinline__ int brev14(int k) { return (int)(__brev((unsigned)k) >> 18); }

__device__ void filter_spectra(const KArgs& a, int l, float2* X, float* w3s) {
    const int tid = tidx();
    const float* H2 = (const float*)(a.ws + WS_H2);
    float4* SP = (float4*)(a.ws + WS_SP);
    const float* w3 = a.in[16] + (size_t)l * 64 * 1024; const float* dec = a.in[17] + (size_t)l * 1024;
    for (int item = bidx(); item < 256; item += gdim()) {
        const int o = item >> 7, cp = item & 127, c = 2 * cp;
        if (tid < 256) { const int k = tid >> 2, q = tid & 3; w3s[k * 4 + q] = w3[(size_t)k * 1024 + o * 512 + (q >> 1) * 256 + c + (q & 1)]; }
        const float dc0 = fabsf(dec[o * 512 + c]), dc1 = fabsf(dec[o * 512 + c + 1]), dc2 = fabsf(dec[o * 512 + 256 + c]), dc3 = fabsf(dec[o * 512 + 256 + c + 1]);
        __syncthreads();
#pragma unroll 1
        for (int i = 0; i < 16; ++i) {
            const int t = tid + 512 * i;
            const float4* hrow = (const float4*)(H2 + (size_t)t * 64);
            float d0 = 0.f, d1 = 0.f, d2 = 0.f, d3 = 0.f;
#pragma unroll 2
            for (int k4 = 0; k4 < 16; ++k4) { const float4 hv = hrow[k4]; const float hh[4] = {hv.x, hv.y, hv.z, hv.w};
#pragma unroll
                for (int kk = 0; kk < 4; ++kk) { const float4 w = *(const float4*)(w3s + (k4 * 4 + kk) * 4); d0 += hh[kk] * w.x; d1 += hh[kk] * w.y; d2 += hh[kk] * w.z; d3 += hh[kk] * w.w; } }
            const float tp = (float)t * (1.0f / 8191.0f);
            X[t] = make_float2(d0 * __expf(-tp * dc0), d1 * __expf(-tp * dc1));
            if (t >= 1) X[FN - t] = make_float2(d2 * __expf(-tp * dc2), d3 * __expf(-tp * dc3)); else X[FN / 2] = make_float2(0.f, 0.f);
        }
        __syncthreads();
        fft_fwd(X, tid);
        const float sc = 1.0f / (float)FN;
#pragma unroll 2
        for (int j = 0; j < 16; ++j) {
            const int s = tid + 512 * j, p = 2 * s, k = brev14(p), p2 = brev14((FN - k) & (FN - 1));
            const float2 G1 = X[p], G2 = X[p2];
            SP[(size_t)item * SPP + s] = make_float4(0.5f * sc * (G1.x + G2.x), 0.5f * sc * (G1.y - G2.y), 0.5f * sc * (G1.y + G2.y), -0.5f * sc * (G1.x - G2.x));
        }
        if (tid == 0) { const float2 G1 = X[1]; SP[(size_t)item * SPP + 8192] = make_float4(sc * G1.x, 0.f, sc * G1.y, 0.f); }
        __syncthreads();
    }
}
__device__ __forceinline__ void spec_mul(float2* X, const float4* sp, int tid) {
#pragma unroll 2
    for (int j = 0; j < 16; ++j) {
        const int s = tid + 512 * j, p = 2 * s, k = brev14(p), p2 = brev14((FN - k) & (FN - 1));
        const float4 g = sp[s];
        const float2 Z1 = X[p], Z2 = X[p2];
        const float ax = 0.5f * (Z1.x + Z2.x), ay = 0.5f * (Z1.y - Z2.y), bx = 0.5f * (Z1.y + Z2.y), by = -0.5f * (Z1.x - Z2.x);
        const float agx = ax * g.x - ay * g.y, agy = ax * g.y + ay * g.x, bgx = bx * g.z - by * g.w, bgy = bx * g.w + by * g.z;
        X[p2] = make_float2(agx + bgy, -agy + bgx);
        X[p] = make_float2(agx - bgy, agy + bgx);
    }
    if (tid == 0) { const float4 g = sp[8192]; const float2 Z1 = X[1]; X[1] = make_float2(Z1.x * g.x, Z1.y * g.z); }
    __syncthreads();
}
__device__ __forceinline__ float2 conv_pair(const bf16_t* pr, int t, int col, const float* cw, const float* cb) {
    asm volatile("" : "+v"(t));
    const unsigned* p0 = (const unsigned*)(pr + (size_t)t * NPROJ + col);
    const unsigned m0 = *p0;
    unsigned mm = *(t >= 1 ? p0 - NPROJ / 2 : p0);
    unsigned mp = *(t + 1 < SEQ ? p0 + NPROJ / 2 : p0);
    mm = t >= 1 ? mm : 0u; mp = t + 1 < SEQ ? mp : 0u;
    float2 r;
    r.x = cb[col] + cw[col] * bf_lo(mm) + cw[768 + col] * bf_lo(m0) + cw[1536 + col] * bf_lo(mp);
    r.y = cb[col + 1] + cw[col + 1] * bf_hi(mm) + cw[768 + col + 1] * bf_hi(m0) + cw[1536 + col + 1] * bf_hi(mp);
    return r;
}
__device__ void hyena_phase(const KArgs& a, int l, float2* X) {
    const int tid = tidx();
    const bf16_t* proj = (const bf16_t*)(a.ws + WS_PROJ); bf16_t* ys = (bf16_t*)(a.ws + WS_YS);
    const float4* SP = (const float4*)(a.ws + WS_SP);
    const float* cw = a.in[9] + (size_t)l * 3 * 768; const float* cb = a.in[10] + (size_t)l * 768; const float* hb = a.in[18] + (size_t)l * 512;
    for (int item = bidx(); item < GS * 128; item += gdim()) {
        const int s = item >> 7, cp = item & 127, c = 2 * cp;
        const bf16_t* pr = proj + (size_t)s * SEQ * NPROJ;
        float2 vreg[16], zreg[16];
#pragma unroll
        for (int i = 0; i < 16; ++i) { const int t = tid + 512 * i; vreg[i] = conv_pair(pr, t, c, cw, cb); X[t] = vreg[i]; X[t + SEQ] = make_float2(0.f, 0.f); if ((i & 3) == 3) __builtin_amdgcn_sched_barrier(0); }
        __syncthreads();
        fft_fwd(X, tid); spec_mul(X, SP + (size_t)cp * SPP, tid); fft_inv(X, tid);
        const float b00 = hb[c], b01 = hb[c + 1], b10 = hb[256 + c], b11 = hb[256 + c + 1];
#pragma unroll
        for (int i = 0; i < 16; ++i) { const int t = tid + 512 * i; const float2 y = X[t]; const float2 x1 = conv_pair(pr, t, 256 + c, cw, cb);
            zreg[i] = make_float2(x1.x * (y.x + b00 * vreg[i].x), x1.y * (y.y + b01 * vreg[i].y)); if ((i & 3) == 3) __builtin_amdgcn_sched_barrier(0); }
        __syncthreads();
#pragma unroll
        for (int i = 0; i < 16; ++i) { const int t = tid + 512 * i; X[t] = zreg[i]; X[t + SEQ] = make_float2(0.f, 0.f); }
        __syncthreads();
        fft_fwd(X, tid); spec_mul(X, SP + (size_t)(128 + cp) * SPP, tid); fft_inv(X, tid);
#pragma unroll
        for (int i = 0; i < 16; ++i) { const int t = tid + 512 * i; const float2 y = X[t]; const float2 x2 = conv_pair(pr, t, 512 + c, cw, cb);
            *(unsigned*)(ys + (size_t)(s * SEQ + t) * 1024 + c) = pk_bf16(x2.x * (y.x + b10 * zreg[i].x), x2.y * (y.y + b11 * zreg[i].y)); if ((i & 3) == 3) __builtin_amdgcn_sched_barrier(0); }
        __syncthreads();
    }
}

__device__ void norm_rows(const float* xsrc, float* xdst, const bf16_t* tmp, const float* w_post, float scale, const float* w_pre, bf16_t* xn) {
    const int wave = tidx() >> 6, lane = tidx() & 63;
    for (int r = bidx() * 8 + wave; r < MG; r += gdim() * 8) {
        float x[16];
#pragma unroll
        for (int hh = 0; hh < 2; ++hh) { const float4* p = (const float4*)(xsrc + (size_t)r * 1024 + hh * 512 + lane * 8); const float4 v0 = p[0], v1 = p[1];
            x[hh * 8 + 0] = v0.x; x[hh * 8 + 1] = v0.y; x[hh * 8 + 2] = v0.z; x[hh * 8 + 3] = v0.w; x[hh * 8 + 4] = v1.x; x[hh * 8 + 5] = v1.y; x[hh * 8 + 6] = v1.z; x[hh * 8 + 7] = v1.w; }
        if (tmp) {
            float tv[16]; float ss = 0.f;
#pragma unroll
            for (int hh = 0; hh < 2; ++hh) { const u32x4 w = *(const u32x4*)(tmp + (size_t)r * 1024 + hh * 512 + lane * 8);
                tv[hh * 8 + 0] = bf_lo(w.x); tv[hh * 8 + 1] = bf_hi(w.x); tv[hh * 8 + 2] = bf_lo(w.y); tv[hh * 8 + 3] = bf_hi(w.y); tv[hh * 8 + 4] = bf_lo(w.z); tv[hh * 8 + 5] = bf_hi(w.z); tv[hh * 8 + 6] = bf_lo(w.w); tv[hh * 8 + 7] = bf_hi(w.w); }
#pragma unroll
            for (int i = 0; i < 16; ++i) ss += tv[i] * tv[i];
            ss = wave_sum(ss);
            const float rs = scale * rsqrtf(ss * (1.0f / 1024.0f) + EPS);
#pragma unroll
            for (int hh = 0; hh < 2; ++hh) { const float4* wp = (const float4*)(w_post + hh * 512 + lane * 8); const float4 w0 = wp[0], w1 = wp[1];
                const float ww[8] = {w0.x, w0.y, w0.z, w0.w, w1.x, w1.y, w1.z, w1.w};
#pragma unroll
                for (int i = 0; i < 8; ++i) x[hh * 8 + i] += tv[hh * 8 + i] * rs * ww[i]; }
        }
        if (xdst) {
#pragma unroll
            for (int hh = 0; hh < 2; ++hh) { float4* p = (float4*)(xdst + (size_t)r * 1024 + hh * 512 + lane * 8);
                p[0] = make_float4(x[hh * 8 + 0], x[hh * 8 + 1], x[hh * 8 + 2], x[hh * 8 + 3]); p[1] = make_float4(x[hh * 8 + 4], x[hh * 8 + 5], x[hh * 8 + 6], x[hh * 8 + 7]); }
        }
        if (xn) {
            float ss = 0.f;
#pragma unroll
            for (int i = 0; i < 16; ++i) ss += x[i] * x[i];
            ss = wave_sum(ss);
            const float rs = rsqrtf(ss * (1.0f / 1024.0f) + EPS);
#pragma unroll
            for (int hh = 0; hh < 2; ++hh) { const float4* wp = (const float4*)(w_pre + hh * 512 + lane * 8); const float4 w0 = wp[0], w1 = wp[1];
                const float ww[8] = {w0.x, w0.y, w0.z, w0.w, w1.x, w1.y, w1.z, w1.w};
                u32x4 o; o.x = pk_bf16(x[hh * 8 + 0] * rs * ww[0], x[hh * 8 + 1] * rs * ww[1]); o.y = pk_bf16(x[hh * 8 + 2] * rs * ww[2], x[hh * 8 + 3] * rs * ww[3]);
                o.z = pk_bf16(x[hh * 8 + 4] * rs * ww[4], x[hh * 8 + 5] * rs * ww[5]); o.w = pk_bf16(x[hh * 8 + 6] * rs * ww[6], x[hh * 8 + 7] * rs * ww[7]);
                *(u32x4*)(xn + (size_t)r * 1024 + hh * 512 + lane * 8) = o; }
        }
    }
}

__device__ __forceinline__ void unpack8(const u32x4 w, float (&f)[8]) { f[0] = bf_lo(w.x); f[1] = bf_hi(w.x); f[2] = bf_lo(w.y); f[3] = bf_hi(w.y); f[4] = bf_lo(w.z); f[5] = bf_hi(w.z); f[6] = bf_lo(w.w); f[7] = bf_hi(w.w); }
__device__ __forceinline__ u32x4 pack8(const float (&f)[8]) { u32x4 w; w.x = pk_bf16(f[0], f[1]); w.y = pk_bf16(f[2], f[3]); w.z = pk_bf16(f[4], f[5]); w.w = pk_bf16(f[6], f[7]); return w; }
__device__ void prescan_phase(const KArgs& a, int l) {
    const bf16_t* proj = (const bf16_t*)(a.ws + WS_PROJ); bf16_t* sc = (bf16_t*)(a.ws + WS_SC); float* dta = (float*)(a.ws + WS_DTA);
    const float* mcw = a.in[19] + (size_t)l * 3 * 512; const float* mcb = a.in[20] + (size_t)l * 512;
    const float* dtb = a.in[21] + l * 8; const float* alog = a.in[22] + l * 8;
    const float* wg2 = a.in[25] + (size_t)l * 2 * 16 * 128; const float* bg = a.in[26] + (size_t)l * 256;
    const float* lbp = a.in[28];
    const int total = MG * 161;
    for (int idx = bidx() * 512 + tidx(); idx < total; idx += gdim() * 512) {
        const int tok = idx / 161, ch = idx - tok * 161, t = tok & (SEQ - 1);
        const bf16_t* row = proj + (size_t)tok * NPROJ;
        if (ch < 64) {
            const int c0 = ch * 8; float x0[8], xm[8], xp[8], o[8];
            unpack8(*(const u32x4*)(row + C_XBC + c0), x0);
            if (t >= 1) unpack8(*(const u32x4*)(row - NPROJ + C_XBC + c0), xm); else { for (int i = 0; i < 8; ++i) xm[i] = 0.f; }
            if (t + 1 < SEQ) unpack8(*(const u32x4*)(row + NPROJ + C_XBC + c0), xp); else { for (int i = 0; i < 8; ++i) xp[i] = 0.f; }
#pragma unroll
            for (int i = 0; i < 8; ++i) o[i] = siluf_(mcb[c0 + i] + mcw[c0 + i] * xm[i] + mcw[512 + c0 + i] * x0[i] + mcw[1024 + c0 + i] * xp[i]);
            *(u32x4*)(sc + (size_t)tok * SCW + c0) = pack8(o);
        } else if (ch == 64) {
            float z[8]; unpack8(*(const u32x4*)(row + C_DT), z);
            float dt[8], av[8];
#pragma unroll
            for (int i = 0; i < 8; ++i) { dt[i] = softplusf_(z[i] + dtb[i]); av[i] = __expf(-dt[i] * __expf(alog[i])); }
            float4* d = (float4*)(dta + (size_t)tok * 16);
            d[0] = make_float4(dt[0], dt[1], dt[2], dt[3]); d[1] = make_float4(dt[4], dt[5], dt[6], dt[7]);
            d[2] = make_float4(av[0], av[1], av[2], av[3]); d[3] = make_float4(av[4], av[5], av[6], av[7]);
        } else if (ch < 97) {
            const int gc = ch - 65, dir = gc >> 4, k0 = (gc & 15) * 8;
            float ga[16];
            { float t8[8]; unpack8(*(const u32x4*)(row + C_GA + dir * 16), t8); for (int i = 0; i < 8; ++i) ga[i] = t8[i];
              unpack8(*(const u32x4*)(row + C_GA + dir * 16 + 8), t8); for (int i = 0; i < 8; ++i) ga[8 + i] = t8[i]; }
            float o[8];
#pragma unroll
            for (int i = 0; i < 8; ++i) o[i] = bg[dir * 128 + k0 + i];
#pragma unroll
            for (int r = 0; r < 16; ++r) { const float4* wp = (const float4*)(wg2 + (size_t)(dir * 16 + r) * 128 + k0); const float4 w0 = wp[0], w1 = wp[1];
                o[0] += ga[r] * w0.x; o[1] += ga[r] * w0.y; o[2] += ga[r] * w0.z; o[3] += ga[r] * w0.w; o[4] += ga[r] * w1.x; o[5] += ga[r] * w1.y; o[6] += ga[r] * w1.z; o[7] += ga[r] * w1.w; }
#pragma unroll
            for (int i = 0; i < 8; ++i) { const float ls = -softplusf_(-o[i]); o[i] = 1.0f - __expf(ls * (1.0f / 16.0f)); }
            *(u32x4*)(sc + (size_t)tok * SCW + 512 + dir * 128 + k0) = pack8(o);
        } else {
            const int hc = ch - 97, dir = hc >> 5, i0 = (hc & 31) * 8;
            float z[8], o[8]; unpack8(*(const u32x4*)(row + C_HF + hc * 8), z);
#pragma unroll
            for (int i = 0; i < 8; ++i) { float lb = 0.f;
                if (l > 0) { const float p0 = lbp[dir * 256 + i0 + i], p1 = lbp[512 + dir * 256 + i0 + i]; lb = sigmoidf_(p1 - p0); }
                o[i] = (1.0f - lb) * __builtin_amdgcn_rcpf(1.0f + __expf(z[i])); }
            *(u32x4*)(sc + (size_t)tok * SCW + 768 + hc * 8) = pack8(o);
        }
    }
}

template <int MODE>
__device__ __forceinline__ void scan_chain(const bf16_t* qp, const bf16_t* kp, const bf16_t* vp, const bf16_t* ap, const float* dp,
                                           bf16_t* op, int pq, int pk, int pv, int pa, int dir, int lane) {
    constexpr int DPL = MODE == 0 ? 2 : 4;
    constexpr int U = 8;
    float S[DPL];
#pragma unroll
    for (int i = 0; i < DPL; ++i) S[i] = 0.f;
    unsigned Q0[2][U], Q1[2][U], K0[2][U], K1[2][U], A0[2][U]; unsigned short V[2][U]; float DT[2][U], AS[2][U];
#define SC_LOAD(bi, base) do { _Pragma("unroll") for (int u = 0; u < U; ++u) { const int st = (base) + u; const size_t tt = (size_t)(dir ? (SEQ - 1 - st) : st); \
        if (DPL == 4) { const u32x2 q = *(const u32x2*)(qp + tt * pq); Q0[bi][u] = q.x; Q1[bi][u] = q.y; const u32x2 k = *(const u32x2*)(kp + tt * pk); K0[bi][u] = k.x; K1[bi][u] = k.y; } \
        else { Q0[bi][u] = *(const unsigned*)(qp + tt * pq); K0[bi][u] = *(const unsigned*)(kp + tt * pk); A0[bi][u] = *(const unsigned*)(ap + tt * pa); } \
        V[bi][u] = vp[tt * pv]; \
        if (MODE == 2) { DT[bi][u] = dp[tt * 16]; AS[bi][u] = dp[tt * 16 + 8]; } } } while (0)
#define SC_COMP(bi, base) do { _Pragma("unroll") for (int u = 0; u < U; ++u) { const int st = (base) + u; const size_t tt = (size_t)(dir ? (SEQ - 1 - st) : st); \
        float v = bf2f(V[bi][u]); float o; \
        if (MODE == 0) { const float q0 = bf_lo(Q0[bi][u]), q1 = bf_hi(Q0[bi][u]), k0 = bf_lo(K0[bi][u]), k1 = bf_hi(K0[bi][u]), m0 = bf_lo(A0[bi][u]), m1 = bf_hi(A0[bi][u]); \
            S[0] = (S[0] - m0 * S[0]) + k0 * v; S[1] = (S[1] - m1 * S[1]) + k1 * v; o = S[0] * q0 + S[1] * q1; } \
        else { const float q0 = bf_lo(Q0[bi][u]), q1 = bf_hi(Q0[bi][u]), q2 = bf_lo(Q1[bi][u]), q3 = bf_hi(Q1[bi][u]); \
            const float k0 = bf_lo(K0[bi][u]), k1 = bf_hi(K0[bi][u]), k2 = bf_lo(K1[bi][u]), k3 = bf_hi(K1[bi][u]); \
            if (MODE == 1) { S[0] += k0 * (v - S[0]); S[1] += k1 * (v - S[1]); S[2] += k2 * (v - S[2]); S[3] += k3 * (v - S[3]); } \
            else { v *= DT[bi][u]; const float aa = AS[bi][u]; S[0] = aa * S[0] + k0 * v; S[1] = aa * S[1] + k1 * v; S[2] = aa * S[2] + k2 * v; S[3] = aa * S[3] + k3 * v; } \
            o = (S[0] * q0 + S[1] * q1) + (S[2] * q2 + S[3] * q3); } \
        o += __shfl_xor(o, 4); o += __shfl_xor(o, 8); o += __shfl_xor(o, 16); o += __shfl_xor(o, 32); \
        if (lane < 4) op[tt * 768] = f2bf(o); } } while (0)
    SC_LOAD(0, 0);
    for (int b = 0; b < SEQ; b += 2 * U) {
        SC_LOAD(1, b + U);
        SC_COMP(0, b);
        if (b + 2 * U < SEQ) SC_LOAD(0, b + 2 * U);
        SC_COMP(1, b + U);
    }
#undef SC_LOAD
#undef SC_COMP
}
__device__ void scan_phase(const KArgs& a) {
    const bf16_t* proj = (const bf16_t*)(a.ws + WS_PROJ); const bf16_t* sc = (const bf16_t*)(a.ws + WS_SC); const float* dta = (const float*)(a.ws + WS_DTA);
    bf16_t* so = (bf16_t*)(a.ws + WS_SO);
    const int wave = tidx() >> 6, lane = tidx() & 63, esub = lane & 3, dgrp = lane >> 2;
    for (int item = wave * gdim() + bidx(); item < GS * 3 * 4 * 2 * 16; item += 8 * gdim()) {
        const int sp = item & 15, dir = (item >> 4) & 1, h = (item >> 5) & 3, s = (item >> 7) % GS, br = (item >> 7) / GS;
        const size_t t0 = (size_t)s * SEQ;
        const int e = sp * 4 + esub;
        bf16_t* op = so + ((size_t)dir * MG + t0) * 768 + br * 256 + h * 64 + e;
        if (br == 0) {
            const int grp = h >> 1;
            scan_chain<2>(sc + t0 * SCW + 384 + grp * 64 + dgrp * 4, sc + t0 * SCW + 256 + grp * 64 + dgrp * 4, sc + t0 * SCW + h * 64 + e, nullptr,
                          dta + t0 * 16 + dir * 4 + h, op, SCW, SCW, SCW, 0, dir, lane);
        } else if (br == 1) {
            scan_chain<0>(proj + t0 * NPROJ + C_GQ + h * 32 + dgrp * 2, proj + t0 * NPROJ + C_GK + h * 32 + dgrp * 2, proj + t0 * NPROJ + C_GV + h * 64 + e,
                          sc + t0 * SCW + 512 + dir * 128 + h * 32 + dgrp * 2, nullptr, op, NPROJ, NPROJ, NPROJ, SCW, dir, lane);
        } else {
            scan_chain<1>(proj + t0 * NPROJ + C_HQ + h * 64 + dgrp * 4, sc + t0 * SCW + 768 + dir * 256 + h * 64 + dgrp * 4, proj + t0 * NPROJ + C_HI + h * 64 + e,
                          nullptr, nullptr, op, NPROJ, SCW, NPROJ, 0, dir, lane);
        }
    }
}


constexpr int CP = 72;
constexpr int L_CB = 0, L_PART = 16640, L_REF = 18688, L_TOT = 18944, L_QP = 19200, L_KP = 28416, L_QI = 37632, L_VT = 46848, L_ST = 56064, L_ATT = 65280;
__device__ __forceinline__ f32x4 mm16(const bf16_t* A, const bf16_t* B, int mt, int nt, int K, int fr, int fq, f32x4 acc) {
    const bf16_t* ap = A + (mt * 16 + fr) * CP + fq * 8; const bf16_t* bp = B + (nt * 16 + fr) * CP + fq * 8;
    for (int k0 = 0; k0 < K; k0 += 32) { const bf16x8 av = *(const bf16x8*)(ap + k0); const bf16x8 bv = *(const bf16x8*)(bp + k0); acc = __builtin_amdgcn_mfma_f32_16x16x32_bf16(av, bv, acc, 0, 0, 0); }
    return acc;
}
__device__ __forceinline__ float* chain_state(unsigned char* ws, int br, int c16) {
    return br == 0 ? (float*)(ws + WS_TMP) + (size_t)c16 * 128 * 4096 : br == 2 ? (float*)(ws + WS_STH) + (size_t)c16 * 128 * 4096 : (float*)(ws + WS_STG) + (size_t)c16 * 128 * 2048;
}
template <bool PHASE_C>
__device__ void chunk_phase(const KArgs& a, int l, unsigned char* L) {
    const bf16_t* proj = (const bf16_t*)(a.ws + WS_PROJ); const bf16_t* sc = (const bf16_t*)(a.ws + WS_SC); const float* dta = (const float*)(a.ws + WS_DTA);
    bf16_t* so = (bf16_t*)(a.ws + WS_SO); float* dcb = (float*)(a.ws + WS_DC);
    const float* alog = a.in[22] + l * 8;
    float* cbS = (float*)(L + L_CB); float* partS = (float*)(L + L_PART); float* refS = (float*)(L + L_REF); float* totS = (float*)(L + L_TOT);
    bf16_t* qpS = (bf16_t*)(L + L_QP); bf16_t* kpS = (bf16_t*)(L + L_KP); bf16_t* qiS = (bf16_t*)(L + L_QI); bf16_t* vT = (bf16_t*)(L + L_VT); bf16_t* sT = (bf16_t*)(L + L_ST); bf16_t* attS = (bf16_t*)(L + L_ATT);
    const int tid = tidx(), row = tid >> 3, c8 = (tid & 7) * 8, wave = tid >> 6, lane = tid & 63, fr = lane & 15, fq = lane >> 4;
#pragma unroll 1
    for (int item = bidx(); item < 48 * 128; item += gdim()) {
        const int ci = item % 48, chunk = item / 48;
        const int br = ci >> 4, c16 = ci & 15, s = c16 >> 3, h = (c16 >> 1) & 3, dir = c16 & 1;
        const int dk = br == 1 ? 32 : 64;
        const size_t tok = (size_t)s * SEQ + chunk * 64 + row;
        const bf16_t *qp, *kp, *gp, *vp;
        if (br == 0) { const int grp = h >> 1; qp = sc + tok * SCW + 384 + grp * 64; kp = sc + tok * SCW + 256 + grp * 64; gp = kp; vp = sc + tok * SCW + h * 64; }
        else if (br == 1) { qp = proj + tok * NPROJ + C_GQ + h * 32; kp = proj + tok * NPROJ + C_GK + h * 32; gp = sc + tok * SCW + 512 + dir * 128 + h * 32; vp = proj + tok * NPROJ + C_GV + h * 64; }
        else { qp = proj + tok * NPROJ + C_HQ + h * 64; kp = sc + tok * SCW + 768 + dir * 256 + h * 64; gp = kp; vp = proj + tok * NPROJ + C_HI + h * 64; }
        const bool act = c8 < dk;
        u32x4 qv = {0u, 0u, 0u, 0u}, kv = {0u, 0u, 0u, 0u}, gv = {0u, 0u, 0u, 0u};
        const u32x4 vv = *(const u32x4*)(vp + c8);
        if (act) { kv = *(const u32x4*)(kp + c8); if (br == 1) gv = *(const u32x4*)(gp + c8); else gv = kv; if (PHASE_C) qv = *(const u32x4*)(qp + c8); }
        float dt = 1.f, gm = 0.f;
        if (br == 0) { dt = dta[tok * 16 + dir * 4 + h]; gm = -dt * __expf(alog[dir * 4 + h]); }
        float* stp = chain_state(a.ws, br, c16) + (size_t)chunk * 64 * dk;
        f32x4 sv0 = {0.f, 0.f, 0.f, 0.f}, sv1 = {0.f, 0.f, 0.f, 0.f};
        if (PHASE_C && act) { const f32x4* sp = (const f32x4*)(stp + (size_t)row * dk + c8); sv0 = sp[0]; sv1 = sp[1]; }
        float kf[8], gf[8];
        unpack8(kv, kf); unpack8(gv, gf);
        if (act) {
#pragma unroll
            for (int j = 0; j < 8; ++j) { const float g = br == 0 ? gm : fmaxf(__logf(fmaxf(1.0f - gf[j], 1e-30f)), -60.f); cbS[row * 65 + c8 + j] = g; }
        }
        __syncthreads();
        {
            const int d = tid & 63, part = tid >> 6; float loc[8]; float run = 0.f;
#pragma unroll
            for (int i = 0; i < 8; ++i) { const int u = part * 8 + i, t = dir ? 63 - u : u; run += cbS[t * 65 + d]; loc[i] = run; }
            partS[part * 64 + d] = run;
            __syncthreads();
            float off = 0.f;
#pragma unroll
            for (int p = 0; p < 8; ++p) off += (p < part) ? partS[p * 64 + d] : 0.f;
#pragma unroll
            for (int i = 0; i < 8; ++i) { const int u = part * 8 + i, t = dir ? 63 - u : u; cbS[t * 65 + d] = off + loc[i]; }
            if (part == 3) refS[d] = off + loc[7];
            if (part == 7) totS[d] = off + loc[7];
        }
        __syncthreads();
        {
            float vf[8]; unpack8(vv, vf);
#pragma unroll
            for (int j = 0; j < 8; ++j) vT[(c8 + j) * CP + row] = f2bf(vf[j] * dt);
            if (act) {
                if (PHASE_C) {
                    float qf[8], qo[8], ko[8], qi[8]; unpack8(qv, qf);
#pragma unroll
                    for (int j = 0; j < 8; ++j) { const float cb = cbS[row * 65 + c8 + j];
                        if (br == 0) { qo[j] = qf[j]; ko[j] = kf[j]; }
                        else { const float eq = fminf(fmaxf(cb - refS[c8 + j], -60.f), 60.f); qo[j] = qf[j] * __expf(eq); ko[j] = kf[j] * __expf(-eq); }
                        qi[j] = qf[j] * __expf(cb); }
                    *(u32x4*)(qpS + row * CP + c8) = pack8(qo); *(u32x4*)(kpS + row * CP + c8) = pack8(ko); *(u32x4*)(qiS + row * CP + c8) = pack8(qi);
                    float sf[8] = {sv0[0], sv0[1], sv0[2], sv0[3], sv1[0], sv1[1], sv1[2], sv1[3]};
                    *(u32x4*)(sT + row * CP + c8) = pack8(sf);
                } else {
#pragma unroll
                    for (int j = 0; j < 8; ++j) { const float cb = cbS[row * 65 + c8 + j]; qiS[(c8 + j) * CP + row] = f2bf(kf[j] * __expf(totS[c8 + j] - cb)); }
                }
            }
        }
        __syncthreads();
        if (PHASE_C) {
#pragma unroll
            for (int i = 0; i < 2; ++i) {
                const int ti = wave * 2 + i, mt = ti >> 2, nt = ti & 3;
                f32x4 acc = {0.f, 0.f, 0.f, 0.f};
                const bool live = dir ? (nt >= mt) : (nt <= mt);
                if (live) acc = mm16(qpS, kpS, mt, nt, dk, fr, fq, acc);
#pragma unroll
                for (int j = 0; j < 4; ++j) { const int t = mt * 16 + fq * 4 + j, sx = nt * 16 + fr; const bool valid = dir ? (sx >= t) : (sx <= t);
                    float v = acc[j];
                    if (br == 0) v *= __expf(fminf(cbS[t * 65] - cbS[sx * 65], 0.f));
                    attS[t * CP + sx] = f2bf(valid ? v : 0.f); }
            }
            __syncthreads();
#pragma unroll
            for (int i = 0; i < 2; ++i) {
                const int ti = wave * 2 + i, mt = ti >> 2, nt = ti & 3;
                f32x4 acc = {0.f, 0.f, 0.f, 0.f};
                acc = mm16(attS, vT, mt, nt, 64, fr, fq, acc);
                acc = mm16(qiS, sT, mt, nt, dk, fr, fq, acc);
                bf16_t* op = so + ((size_t)dir * MG + (size_t)s * SEQ + chunk * 64 + mt * 16 + fq * 4) * 768 + br * 256 + h * 64 + nt * 16 + fr;
#pragma unroll
                for (int j = 0; j < 4; ++j) op[(size_t)j * 768] = f2bf(acc[j]);
            }
        } else {
#pragma unroll
            for (int i = 0; i < 2; ++i) {
                const int ti = wave * 2 + i, mt = ti >> 2, nt = ti & 3;
                if (nt * 16 < dk) {
                    f32x4 acc = {0.f, 0.f, 0.f, 0.f};
                    acc = mm16(vT, qiS, mt, nt, 64, fr, fq, acc);
                    float* dp = stp + (size_t)(mt * 16 + fq * 4) * dk + nt * 16 + fr;
#pragma unroll
                    for (int j = 0; j < 4; ++j) dp[(size_t)j * dk] = acc[j];
                }
            }
            if (tid < dk) dcb[((size_t)ci * 128 + chunk) * 64 + tid] = __expf(totS[tid]);
        }
        __syncthreads();
    }
}
__device__ void chunk_carry(const KArgs& a) {
    const float* dcb = (const float*)(a.ws + WS_DC);
    const int nthr = gdim() * 512;
#pragma unroll 1
    for (int idx = bidx() * 512 + tidx(); idx < 16 * 4096 * 2 + 16 * 2048; idx += nthr) {
        int br, rem = idx;
        if (rem < 16 * 4096) br = 0; else if ((rem -= 16 * 4096) < 16 * 4096) br = 2; else { rem -= 16 * 4096; br = 1; }
        const int dk = br == 1 ? 32 : 64, per = 64 * dk;
        const int c16 = rem / per, ed = rem - c16 * per, d = ed & (dk - 1), dir = c16 & 1;
        float* st = chain_state(a.ws, br, c16) + ed;
        const float* dc = dcb + ((size_t)(br * 16 + c16) * 128) * 64 + d;
        float state = 0.f;
#pragma unroll 1
        for (int s0 = 0; s0 < 128; s0 += 8) {
            float tv[8], dv[8];
#pragma unroll
            for (int i = 0; i < 8; ++i) { const int c = dir ? 127 - (s0 + i) : s0 + i; tv[i] = st[(size_t)c * per]; dv[i] = dc[(size_t)c * 64]; }
#pragma unroll
            for (int i = 0; i < 8; ++i) { const int c = dir ? 127 - (s0 + i) : s0 + i; st[(size_t)c * per] = state; state = dv[i] * state + tv[i]; }
        }
    }
}

__device__ __forceinline__ void ld4(const bf16_t* p, float (&f)[4]) { const u32x2 w = *(const u32x2*)p; f[0] = bf_lo(w.x); f[1] = bf_hi(w.x); f[2] = bf_lo(w.y); f[3] = bf_hi(w.y); }
__device__ __forceinline__ void st4(bf16_t* p, const float (&f)[4]) { u32x2 w; w.x = pk_bf16(f[0], f[1]); w.y = pk_bf16(f[2], f[3]); *(u32x2*)p = w; }
__device__ void postscan_phase(const KArgs& a, int l) {
    const bf16_t* proj = (const bf16_t*)(a.ws + WS_PROJ); const bf16_t* sc = (const bf16_t*)(a.ws + WS_SC); const bf16_t* so = (const bf16_t*)(a.ws + WS_SO);
    bf16_t* ys = (bf16_t*)(a.ws + WS_YS);
    const float* mD = a.in[23] + l * 4; const float* mN = a.in[24] + l * 256; const float* gN = a.in[27] + l * 64; const float* hN = a.in[29] + l * 64;
    const int wave = tidx() >> 6, lane = tidx() & 63, c4 = lane * 4;
    for (int tok = bidx() * 8 + wave; tok < MG; tok += gdim() * 8) {
        const bf16_t* sf = so + (size_t)tok * 768; const bf16_t* sb = so + ((size_t)MG + tok) * 768; const bf16_t* row = proj + (size_t)tok * NPROJ;
        float of[4], ob[4], g[4], y[4];
        {
            float mx[4]; ld4(sf + c4, of); ld4(sb + c4, ob); ld4(sc + (size_t)tok * SCW + c4, mx); ld4(row + C_M2Z + c4, g);
            const float Dh = mD[lane >> 4]; float ss = 0.f;
#pragma unroll
            for (int j = 0; j < 4; ++j) { y[j] = (of[j] + ob[j] + Dh * mx[j]) * siluf_(g[j]); ss += y[j] * y[j]; }
            ss = wave_sum(ss); const float rs = rsqrtf(ss * (1.0f / 256.0f) + EPS);
#pragma unroll
            for (int j = 0; j < 4; ++j) y[j] *= rs * mN[c4 + j];
            st4(ys + (size_t)tok * 1024 + 256 + c4, y);
        }
        {
            ld4(sf + 256 + c4, of); ld4(sb + 256 + c4, ob); ld4(row + C_GG + c4, g); float ss = 0.f;
#pragma unroll
            for (int j = 0; j < 4; ++j) { y[j] = (of[j] + ob[j]) * 0.17677669529663687f; ss += y[j] * y[j]; }
            ss += __shfl_xor(ss, 1); ss += __shfl_xor(ss, 2); ss += __shfl_xor(ss, 4); ss += __shfl_xor(ss, 8);
            const float rs = rsqrtf(ss * (1.0f / 64.0f) + EPS);
#pragma unroll
            for (int j = 0; j < 4; ++j) y[j] = y[j] * rs * gN[(c4 & 63) + j] * siluf_(g[j]);
            st4(ys + (size_t)tok * 1024 + 512 + c4, y);
        }
        {
            ld4(sf + 512 + c4, of); ld4(sb + 512 + c4, ob); ld4(row + C_HGG + c4, g); float ss = 0.f;
#pragma unroll
            for (int j = 0; j < 4; ++j) { y[j] = (of[j] + ob[j]) * 0.125f; ss += y[j] * y[j]; }
            ss += __shfl_xor(ss, 1); ss += __shfl_xor(ss, 2); ss += __shfl_xor(ss, 4); ss += __shfl_xor(ss, 8);
            const float rs = rsqrtf(ss * (1.0f / 64.0f) + EPS);
#pragma unroll
            for (int j = 0; j < 4; ++j) y[j] = y[j] * rs * hN[(c4 & 63) + j] * siluf_(g[j]);
            st4(ys + (size_t)tok * 1024 + 768 + c4, y);
        }
    }
}


#define XB_TMO      128
#define XB_XCNT(j)  (256  + 64 * (j))
#define XB_XSUB(j)  (1280 + 64 * (j))
#define XB_XGEN(j)  (2304 + 64 * (j))
#define XB_TOP      3328
#define XB_TOPGEN   3392
#define XCD_BAR_WORDS 3456
#define XB_SPIN_CAP (1u << 20)
__device__ __forceinline__ unsigned xb_ld(unsigned* p)              { return __hip_atomic_load(p, __ATOMIC_RELAXED, __HIP_MEMORY_SCOPE_AGENT); }
__device__ __forceinline__ unsigned xb_add(unsigned* p, unsigned v) { return __hip_atomic_fetch_add(p, v, __ATOMIC_RELAXED, __HIP_MEMORY_SCOPE_AGENT); }
__device__ __forceinline__ unsigned xb_xcc_id() { return (unsigned)__builtin_amdgcn_s_getreg((3 << 11) | 20) & 0xFu; }
#define XB_SPIN(cond, bar) do { unsigned _sp = 0; while (cond) { __builtin_amdgcn_s_sleep(1); \
    if ((++_sp & 255u) == 0u) { if (xb_ld(&(bar)[XB_TMO])) break; if (_sp > XB_SPIN_CAP) { atomicAdd(&(bar)[XB_TMO], 1u); break; } } } } while (0)
struct XcdBarrier { unsigned* bar; unsigned x; volatile LAS unsigned* st; };
__device__ __forceinline__ XcdBarrier xcd_barrier_post(unsigned* bar, volatile LAS unsigned* st) {
    XcdBarrier b; b.bar = bar; b.x = xb_xcc_id(); b.st = st;
    if (threadIdx.x == 0) (void)xb_add(&bar[XB_XCNT(b.x)], 1u);
    return b;
}
__device__ __forceinline__ void xcd_barrier_complete(unsigned* bar, unsigned x, unsigned& nloc, unsigned& nx) {
    const unsigned G = gridDim.x * gridDim.y * gridDim.z;
    unsigned sum, cnt, mine, sp = 0u;
    for (;;) {
        sum = 0u; cnt = 0u; mine = 0u;
#pragma unroll
        for (unsigned j = 0; j < 16; ++j) { const unsigned c = xb_ld(&bar[XB_XCNT(j)]); sum += c; cnt += (c > 0u) ? 1u : 0u; mine = (j == x) ? c : mine; }
        if (sum == G) break;
        __builtin_amdgcn_s_sleep(1);
        if ((++sp & 255u) == 0u) { if (xb_ld(&bar[XB_TMO])) break; if (sp > XB_SPIN_CAP) { atomicAdd(&bar[XB_TMO], 1u); break; } }
    }
    nloc = mine > 0u ? mine : 1u; nx = cnt > 0u ? cnt : 1u;
}
__device__ __forceinline__ void xcd_barrier(const XcdBarrier& b) {
    asm volatile("s_waitcnt vmcnt(0)" ::: "memory");
    __syncthreads();
    if (threadIdx.x == 0) {
        unsigned* bar = b.bar;
        __builtin_amdgcn_s_waitcnt(0);
        unsigned nloc = b.st[0], nx = b.st[1];
        if (nloc == 0u) { xcd_barrier_complete(bar, b.x, nloc, nx); b.st[0] = nloc; b.st[1] = nx; }
        const unsigned old = xb_add(&bar[XB_XSUB(b.x)], 1u);
        const unsigned gen = old / nloc;
        if (old + 1u == (gen + 1u) * nloc) {
            __builtin_amdgcn_fence(__ATOMIC_RELEASE, "agent");
            asm volatile("s_waitcnt vmcnt(0)" ::: "memory");
            const unsigned og = xb_add(&bar[XB_TOP], 1u);
            const unsigned tg = og / nx;
            if (og + 1u == (tg + 1u) * nx) xb_add(&bar[XB_TOPGEN], 1u);
            else XB_SPIN(xb_ld(&bar[XB_TOPGEN]) == tg, bar);
            __builtin_amdgcn_fence(__ATOMIC_ACQUIRE, "agent");
            xb_add(&bar[XB_XGEN(b.x)], 1u);
            asm volatile("s_waitcnt vmcnt(0)" ::: "memory");
        } else {
            XB_SPIN(xb_ld(&bar[XB_XGEN(b.x)]) == gen, bar);
            __builtin_amdgcn_fence(__ATOMIC_ACQUIRE, "agent");
            asm volatile("s_waitcnt vmcnt(0)" ::: "memory");
        }
    }
    __syncthreads();
}

__global__ void __launch_bounds__(512) hybrid_fwd(KArgs a) {
    extern __shared__ __attribute__((aligned(16))) unsigned char lds_raw[];
    LAS unsigned char* lds = (LAS unsigned char*)lds_raw;
    cg::grid_group grid = cg::this_grid();
    unsigned char* ws = a.ws;
    const int lo = a.ph_lo, hi = a.ph_hi;
    const int G = gdim(), bid = bidx();
    unsigned* barw = (unsigned*)(ws + WS_BAR);
    if (blockIdx.x == 0) for (int i = threadIdx.x; i < XCD_BAR_WORDS; i += 512) barw[i] = 0u;
    volatile LAS unsigned* bst = (volatile LAS unsigned*)(lds + 133120);
    if (threadIdx.x < 4) bst[threadIdx.x] = 0u;
    __syncthreads();
    grid.sync();
    const XcdBarrier xb = xcd_barrier_post(barw, bst);
#pragma unroll 1
    for (int pc = lo; pc < hi; ++pc) {
        const int l = pc / 56, r = pc - l * 56;
        bf16_t* XN = (bf16_t*)(ws + WS_XN); bf16_t* PROJ = (bf16_t*)(ws + WS_PROJ); bf16_t* ACT = PROJ; bf16_t* YB = PROJ;
        bf16_t* YS = (bf16_t*)(ws + WS_YS); bf16_t* TMP = (bf16_t*)(ws + WS_TMP); bf16_t* MERGED = (bf16_t*)(ws + WS_SO);
        if (r == 0) { prep_weights(a, l, (float*)lds_raw); filter_hidden(a, l, (float*)lds_raw); }
        else if (r == 1) { filter_spectra(a, l, (float2*)lds_raw, (float*)(lds_raw + 131072)); }
        else {
            const int g = (r - 2) / 18, j = (r - 2) - g * 18;
            float* xg = a.out + (size_t)g * MG * 1024;
            if (j == 0 || j == 3 || j == 14 || j == 17) {
                const float* xsrc = xg; float* xdst = xg; const bf16_t* tmp = TMP; const float* wpost = nullptr; const float* wpre = nullptr; float scale = 0.5f; bf16_t* xn = XN;
                if (j == 0) { xsrc = (l == 0) ? ((g < 2) ? a.in[0] + (size_t)g * MG * 1024 : a.in[1]) : xg; xdst = (l == 0) ? xg : nullptr; tmp = nullptr; wpre = a.in[2] + l * 1024; }
                else if (j == 3) { wpost = a.in[3] + l * 1024; wpre = a.in[6] + l * 1024; }
                else if (j == 14) { wpost = a.in[7] + l * 1024; wpre = a.in[32] + l * 1024; scale = 1.0f; }
                else { wpost = a.in[33] + l * 1024; xn = nullptr; }
                norm_rows(xsrc, xdst, tmp, wpost, scale, wpre, xn);
            } else if (j == 1 || j == 15) {
                pg8::Gemm gm{XN, (const bf16_t*)(ws + (j == 1 ? WS_GU1 : WS_GU2)), MG, 5632, 1024, 1024, 1024}; pg8::StaticOrder S; S.init(MG, 5632, G, bid); pg8::EpiSwiGLU E{ACT, DFF}; pg8::gemm_phase(lds, gm, S, E);
            } else if (j == 2 || j == 4 || j == 11 || j == 13 || j == 16) {
                const bf16_t* A = ACT; const bf16_t* Bt = (const bf16_t*)(ws + WS_DN1); int N = 1024, K = DFF, lda = DFF, ldc = 1024, reps = 1; bf16_t* O = TMP;
                if (j == 16) Bt = (const bf16_t*)(ws + WS_DN2);
                else if (j == 4) { A = XN; Bt = (const bf16_t*)(ws + WS_INT); N = NPROJ; K = 1024; lda = 1024; O = PROJ; ldc = NPROJ; }
                else if (j == 11) { A = YS; Bt = (const bf16_t*)(ws + WS_BR); K = 256; lda = 1024; O = YB; ldc = 4096; reps = 4; }
                else if (j == 13) { A = MERGED; Bt = (const bf16_t*)(ws + WS_OUT); K = 1024; lda = 1024; }
#pragma unroll 1
                for (int nb = 0; nb < reps; ++nb) {
                    pg8::Gemm gm{A + nb * 256, Bt + (size_t)nb * 1024 * 256, MG, N, K, lda, K}; pg8::StaticOrder S; S.init(MG, N, G, bid); pg8::EpiBf16 E{O + nb * 1024, ldc}; pg8::gemm_phase(lds, gm, S, E);
                }
            } else if (j == 12) {
                pg8::Gemm gm{XN, (const bf16_t*)(ws + WS_GT), MG, 4096, 1024, 1024, 1024}; pg8::StaticOrder S; S.init(MG, 4096, G, bid); pg8::EpiMerge E{YB, MERGED}; pg8::gemm_phase(lds, gm, S, E);
            } else if (j == 5) prescan_phase(a, l);
            else if (j == 6) hyena_phase(a, l, (float2*)lds_raw);
            else if (j == 7) chunk_phase<false>(a, l, lds_raw);
            else if (j == 8) chunk_carry(a);
            else if (j == 9) chunk_phase<true>(a, l, lds_raw);
            else postscan_phase(a, l);
        }
        if (pc + 1 < hi) xcd_barrier(xb);
    }
}
constexpr int N_PHASES = 2 * (2 + NGRP * 18);

extern "C" void kernel_launch(void* const* d_in, const int* in_sizes, int n_in, void* d_out, int out_size, void* d_ws, size_t ws_size, hipStream_t stream) {
    static int grid = 0;
    if (grid == 0) {
        if (n_in != 36 || ws_size < WS_END) { fprintf(stderr, "kernel_launch: need 36 inputs and %zu bytes of workspace (got %d, %zu)\n", (size_t)WS_END, n_in, ws_size); grid = -1; return; }
        int dev = 0, cus = 0, per_cu = 0;
        (void)hipGetDevice(&dev); (void)hipDeviceGetAttribute(&cus, hipDeviceAttributeMultiprocessorCount, dev);
        if (hipFuncSetAttribute((const void*)hybrid_fwd, hipFuncAttributeMaxDynamicSharedMemorySize, LDS_BYTES) != hipSuccess) { fprintf(stderr, "kernel_launch: hipFuncSetAttribute failed\n"); grid = -1; return; }
        if (hipOccupancyMaxActiveBlocksPerMultiprocessor(&per_cu, (const void*)hybrid_fwd, 512, LDS_BYTES) != hipSuccess || per_cu < 1) { fprintf(stderr, "kernel_launch: occupancy query gave %d\n", per_cu); per_cu = 1; }
        (void)hipGetLastError();
        grid = cus * 1;
    }
    if (grid < 0) return;
    KArgs a{};
    for (int i = 0; i < 36; ++i) a.in[i] = (const float*)d_in[i];
    a.out = (float*)d_out; a.ws = (unsigned char*)d_ws; a.ph_lo = 0; a.ph_hi = N_PHASES;
    void* args[] = {&a};
    hipError_t e = hipLaunchCooperativeKernel((const void*)hybrid_fwd, dim3(grid), dim3(512), args, LDS_BYTES, stream);
    if (e != hipSuccess) fprintf(stderr, "cooperative launch failed: %s (grid %d)\n", hipGetErrorString(e), grid);
}
```
